# Optimizing an MI355X kernel written in HIP

```python
import math
import jax, jax.numpy as jnp
from jax import lax
import numpy as np

D_MODEL = 1024
BATCH = 4
SEQ = 8192
DEPTH = 4

N_A_LAYERS = DEPTH // 2
N_B_LAYERS = DEPTH - N_A_LAYERS
A_HEADS = D_MODEL // 128
A_HEAD_DIM = 64
A_VALUE_DIM = 2 * A_HEAD_DIM
D_ATTN_A = A_HEADS * A_VALUE_DIM
B_HEADS = D_MODEL // 64
B_HEAD_DIM = 64
D_ATTN_B = B_HEADS * B_HEAD_DIM
N_EXPERTS = 32
TOP_K = 4
D_EXPERT = D_MODEL
SWIGLU_ALPHA = 1.702
SWIGLU_LIMIT = 7.0
Q_BLOCK = 128
EXPERT_BLOCK = 128
EPS = 1e-6
NEG_INF = -1e30

kernel_name = 'yoco_diffattn_stickbreaking_moe_adaln'


def rmsnorm(x, gain):
    xf = x.astype(jnp.float32)
    y = xf * lax.rsqrt(jnp.mean(xf * xf, axis=-1, keepdims=True) + EPS)
    return (y * gain.astype(jnp.float32)).astype(x.dtype)


def adaln(x, gain, shift, scale):
    return rmsnorm(x, gain) * (1 + scale) + shift


def alibi_slopes(n_heads):
    return jnp.asarray(np.array([2.0 ** (-8.0 * (i + 1) / n_heads) for i in range(n_heads)], dtype=np.float32))


def to_query_blocks(q):
    b, s = q.shape[0], q.shape[1]
    return jnp.moveaxis(q.reshape((b, s // Q_BLOCK, Q_BLOCK) + q.shape[2:]), 1, 0)


def from_query_blocks(o):
    o = jnp.moveaxis(o, 0, 1)
    return o.reshape((o.shape[0], o.shape[1] * o.shape[2]) + o.shape[3:])


def diff_attention(h, wqkv, wo, lam_vecs, subln, layer_idx):
    b, s, _ = h.shape
    qkv = h @ wqkv
    q, k, v = jnp.split(qkv, 3, axis=-1)
    q = q.reshape(b, s, A_HEADS, 2, A_HEAD_DIM) * (A_HEAD_DIM ** -0.5)
    k = k.reshape(b, s, A_HEADS, 2, A_HEAD_DIM)
    v = v.reshape(b, s, A_HEADS, A_VALUE_DIM)
    lam_init = 0.8 - 0.6 * math.exp(-0.3 * layer_idx)
    lv = lam_vecs.astype(jnp.float32)
    lam = jnp.exp(jnp.sum(lv[0] * lv[1])) - jnp.exp(jnp.sum(lv[2] * lv[3])) + lam_init
    slopes = alibi_slopes(A_HEADS)[:, None, None, None]
    kpos = jnp.arange(s)
    n_blk = s // Q_BLOCK

    def block(args):
        i, qi = args
        qpos = i * Q_BLOCK + jnp.arange(Q_BLOCK)
        dist = (qpos[:, None] - kpos[None, :]).astype(jnp.float32)
        sc = jnp.einsum('bqhrd,bkhrd->bhrqk', qi, k).astype(jnp.float32)
        sc = jnp.where(dist >= 0, sc - slopes * dist, NEG_INF)
        p = jax.nn.softmax(sc, axis=-1)
        attn = p[:, :, 0] - lam * p[:, :, 1]
        return jnp.einsum('bhqk,bkhe->bqhe', attn.astype(v.dtype), v)

    o = from_query_blocks(lax.map(block, (jnp.arange(n_blk), to_query_blocks(q))))
    o = rmsnorm(o, subln) * (1 - lam_init)
    return o.reshape(b, s, D_ATTN_A) @ wo


def stick_breaking_attention(h, wq, wo, k, v):
    b, s, _ = h.shape
    q = (h @ wq).reshape(b, s, B_HEADS, B_HEAD_DIM) * (B_HEAD_DIM ** -0.5)
    kpos = jnp.arange(s)
    n_blk = s // Q_BLOCK

    def block(args):
        i, qi = args
        qpos = i * Q_BLOCK + jnp.arange(Q_BLOCK)
        strict = kpos[None, :] < qpos[:, None]
        z = jnp.einsum('bqhd,bkhd->bhqk', qi, k).astype(jnp.float32)
        log_beta = jax.nn.log_sigmoid(z)
        log_1mb = jnp.where(strict, jax.nn.log_sigmoid(-z), 0.0)
        log_rem = lax.cumsum(log_1mb, axis=3, reverse=True) - log_1mb
        a = jnp.where(strict, jnp.exp(log_beta + log_rem), 0.0)
        return jnp.einsum('bhqk,bkhd->bqhd', a.astype(v.dtype), v)

    o = from_query_blocks(lax.map(block, (jnp.arange(n_blk), to_query_blocks(q))))
    return o.reshape(b, s, D_ATTN_B) @ wo


def clamped_swiglu(g, u):
    g = jnp.minimum(g, SWIGLU_LIMIT)
    u = jnp.clip(u, -SWIGLU_LIMIT, SWIGLU_LIMIT)
    return g * jax.nn.sigmoid(SWIGLU_ALPHA * g) * (u + 1)


def moe(h, rw, rb, wgu, bgu, wd, bd):
    b, s, d = h.shape
    t = b * s
    xt = h.reshape(t, d)
    logits = (xt @ rw + rb).astype(jnp.float32)
    top_vals, top_idx = lax.top_k(logits, TOP_K)
    gates = jax.nn.softmax(top_vals, axis=-1)
    n_assign = t * TOP_K
    e_flat = top_idx.reshape(n_assign)
    order = jnp.argsort(e_flat)
    sorted_e = e_flat[order]
    sorted_tok = (order // TOP_K).astype(jnp.int32)
    sorted_gate = gates.reshape(n_assign)[order]
    counts = jnp.bincount(e_flat, length=N_EXPERTS)
    padded = (counts + EXPERT_BLOCK - 1) // EXPERT_BLOCK * EXPERT_BLOCK
    start = jnp.cumsum(counts) - counts
    pend = jnp.cumsum(padded)
    pstart = pend - padded
    dest = pstart[sorted_e] + (jnp.arange(n_assign) - start[sorted_e])
    n_blocks = (n_assign + N_EXPERTS * (EXPERT_BLOCK - 1) + EXPERT_BLOCK - 1) // EXPERT_BLOCK
    n_rows = n_blocks * EXPERT_BLOCK
    row_tok = jnp.zeros((n_rows,), jnp.int32).at[dest].set(sorted_tok)
    row_gate = jnp.zeros((n_rows,), jnp.float32).at[dest].set(sorted_gate)
    block_e = jnp.minimum(jnp.searchsorted(pend, jnp.arange(n_blocks) * EXPERT_BLOCK, side='right'), N_EXPERTS - 1)

    def expert_block(args):
        tok, e = args
        gu = xt[tok] @ wgu[e] + bgu[e]
        return clamped_swiglu(gu[:, :D_EXPERT], gu[:, D_EXPERT:]) @ wd[e] + bd[e]

    ys = lax.map(expert_block, (row_tok.reshape(n_blocks, EXPERT_BLOCK), block_e)).reshape(n_rows, d)
    ys = ys * row_gate[:, None].astype(ys.dtype)
    return jax.ops.segment_sum(ys, row_tok, num_segments=t).reshape(b, s, d)


def setup_inputs(seed: int = 0) -> dict:
    key = jax.random.key(seed)
    ks = jax.random.split(key, 24)
    f32 = jnp.float32
    D = D_MODEL
    def nrm(k, shape, scale):
        return jax.random.normal(k, shape, f32) * scale
    return {
        'x': nrm(ks[0], (BATCH, SEQ, D), 1.0),
        'c': nrm(ks[1], (BATCH, D), 1.0),
        'ada_w': nrm(ks[2], (DEPTH, D, 6 * D), 0.5 * D ** -0.5),
        'ada_b': nrm(ks[3], (DEPTH, 6 * D), 0.02),
        'norm_mix': 1.0 + nrm(ks[4], (DEPTH, D), 0.02),
        'norm_moe': 1.0 + nrm(ks[5], (DEPTH, D), 0.02),
        'a_wqkv': nrm(ks[6], (N_A_LAYERS, D, 3 * D_ATTN_A), D ** -0.5),
        'a_wo': nrm(ks[7], (N_A_LAYERS, D_ATTN_A, D), D_ATTN_A ** -0.5),
        'a_lambda': nrm(ks[8], (N_A_LAYERS, 4, A_HEAD_DIM), 0.1),
        'a_subln': 1.0 + nrm(ks[9], (N_A_LAYERS, A_VALUE_DIM), 0.02),
        'kv_norm': 1.0 + nrm(ks[10], (D,), 0.02),
        'kv_ada_w': nrm(ks[11], (D, 2 * D), 0.5 * D ** -0.5),
        'kv_ada_b': nrm(ks[12], (2 * D,), 0.02),
        'kv_w': nrm(ks[13], (D, 2 * D_ATTN_B), D ** -0.5),
        'b_wq': nrm(ks[14], (N_B_LAYERS, D, D_ATTN_B), D ** -0.5),
        'b_wo': nrm(ks[15], (N_B_LAYERS, D_ATTN_B, D), D_ATTN_B ** -0.5),
        'router_w': nrm(ks[16], (DEPTH, D, N_EXPERTS), D ** -0.5),
        'router_b': nrm(ks[17], (DEPTH, N_EXPERTS), 0.01),
        'w_gate_up': nrm(ks[18], (DEPTH, N_EXPERTS, D, 2 * D_EXPERT), D ** -0.5),
        'b_gate_up': nrm(ks[19], (DEPTH, N_EXPERTS, 2 * D_EXPERT), 0.02),
        'w_down': nrm(ks[20], (DEPTH, N_EXPERTS, D_EXPERT, D), D_EXPERT ** -0.5),
        'b_down': nrm(ks[21], (DEPTH, N_EXPERTS, D), 0.02),
        'final_norm': 1.0 + nrm(ks[22], (D,), 0.02),
    }


def reference(x, c, ada_w, ada_b, norm_mix, norm_moe, a_wqkv, a_wo, a_lambda, a_subln,
              kv_norm, kv_ada_w, kv_ada_b, kv_w, b_wq, b_wo, router_w, router_b,
              w_gate_up, b_gate_up, w_down, b_down, final_norm):
    b, s, _ = x.shape
    c_act = jax.nn.silu(c)
    k_sh = None
    v_sh = None
    for l in range(DEPTH):
        mod = (c_act @ ada_w[l] + ada_b[l])[:, None, :]
        sh1, sc1, g1, sh2, sc2, g2 = jnp.split(mod, 6, axis=-1)
        h = adaln(x, norm_mix[l], sh1, sc1)
        if l < N_A_LAYERS:
            y = diff_attention(h, a_wqkv[l], a_wo[l], a_lambda[l], a_subln[l], l)
        else:
            if l == N_A_LAYERS:
                kv_mod = (c_act @ kv_ada_w + kv_ada_b)[:, None, :]
                kv_sh, kv_sc = jnp.split(kv_mod, 2, axis=-1)
                kv = adaln(x, kv_norm, kv_sh, kv_sc) @ kv_w
                k_sh, v_sh = jnp.split(kv, 2, axis=-1)
                k_sh = k_sh.reshape(b, s, B_HEADS, B_HEAD_DIM)
                v_sh = v_sh.reshape(b, s, B_HEADS, B_HEAD_DIM)
            j = l - N_A_LAYERS
            y = stick_breaking_attention(h, b_wq[j], b_wo[j], k_sh, v_sh)
        x = x + g1 * y
        h = adaln(x, norm_moe[l], sh2, sc2)
        x = x + g2 * moe(h, router_w[l], router_b[l], w_gate_up[l], b_gate_up[l], w_down[l], b_down[l])
    return rmsnorm(x, final_norm)
```

```cpp
#include <hip/hip_runtime.h>
#include <hip/hip_bf16.h>
#include <cstdio>
#include <cstdint>
#include <cmath>

namespace pg8 {
#define PG8_LAS __attribute__((address_space(3)))
typedef unsigned short bf16_t;
typedef short bf16x8 __attribute__((ext_vector_type(8)));
typedef float f32x4 __attribute__((ext_vector_type(4)));
typedef unsigned u32x4 __attribute__((ext_vector_type(4)));
typedef int v4i_t __attribute__((ext_vector_type(4)));
typedef unsigned u32x2 __attribute__((ext_vector_type(2)));
constexpr int BM = 256, BK = 64, HALF = 128, HTB = HALF * BK * 2  , STAGE_BYTES = 8 * HTB, NXCD = 8, WGM = 8;

__host__ __device__ __forceinline__ int lds_byte(int r, int c) { const int st = (r >> 4) * 2 + (c >> 5), rr = r & 15, cc = c & 31, ob = rr * 64 + cc * 2; return st * 1024 + (ob ^ (((ob >> 9) & 1) << 5)); }
__host__ __device__ __forceinline__ void stage_rc(int b, int& R, int& C) { const int st = b / 1024, sb = b % 1024, swz = sb ^ (((sb >> 9) & 1) << 5); R = (st >> 1) * 16 + swz / 64; C = (st & 1) * 32 + (swz % 64) / 2; }
__host__ __device__ __forceinline__ int perm32(int rho) { const int n = rho >> 4, i = rho & 15; return 8 * (i >> 2) + 4 * n + (i & 3); }

struct Unit { int pm, pn, gl; };
struct Gemm { const bf16_t* A; const bf16_t* Bt; int M, N, K; };

struct StaticOrder {
    int nM, nN, nwg, G, c;
    __host__ __device__ void init(int M, int N, int G_, int c_) { nM = M / BM; nN = N / BM; nwg = nM * nN; G = G_; c = c_; }
    __host__ __device__ bool next(int i, Unit& u) const {
        const long L = (long)i * G + c; if (L >= nwg) return false;
        int wgid = (int)L; { const int q = nwg / NXCD, r = nwg % NXCD, xcd = wgid % NXCD, off = wgid / NXCD; wgid = (xcd < r ? xcd * (q + 1) : r * (q + 1) + (xcd - r) * q) + off; }
        const int nig = WGM * nN, gid = wgid / nig, fm = gid * WGM, gsz = (nM - fm) < WGM ? (nM - fm) : WGM;
        u.pm = fm + ((wgid % nig) % gsz); u.pn = (wgid % nig) / gsz; return true;
    }
    __device__ __forceinline__ void a_ready(const Unit&) const {}
    __device__ __forceinline__ void done(const Unit&) const {}
};


typedef float f32x2 __attribute__((ext_vector_type(2)));
__device__ __forceinline__ unsigned cvt_pk_bf16(float lo, float hi) { unsigned r; asm volatile("v_cvt_pk_bf16_f32 %0, %1, %2" : "=v"(r) : "v"(lo), "v"(hi)); return r; }
__device__ __forceinline__ unsigned cvt_pk4_fp8(float a, float b, float c, float d) { int r = __builtin_amdgcn_cvt_pk_fp8_f32(a, b, 0, false); r = __builtin_amdgcn_cvt_pk_fp8_f32(c, d, r, true); return (unsigned)r; }
constexpr float W8_SCALE = 256.0f, W8_INV = 1.0f / 256.0f;
struct EpiBf16 {
    static constexpr bool PERM = true, AFTER_DRAIN = false;
    bf16_t* O; int ldc; int split_cols; size_t split_stride; float scale0; unsigned* kmaxw; int rows_per_batch;
    __device__ __forceinline__ void operator()(const f32x4 (&acc)[2][2][4][2], const Unit& u, int wr, int wc, int fr, int fq) const {
        const int row0 = u.pm * BM + wr * 64 + fr; int colt = u.pn * BM; bf16_t* base = O;
        float sc = 1.f; int tsel = 0; if (split_cols) { const int t = colt / split_cols; tsel = t; base += (size_t)t * split_stride; colt -= t * split_cols; if (t == 0) sc = scale0; }
        const int col0 = colt + wc * 32 + 8 * fq;
        const bool dok = (kmaxw != nullptr) && (tsel == 1);
        float mx[2] = {0.f, 0.f};
#pragma unroll
        for (int ai = 0; ai < 2; ++ai)
#pragma unroll
            for (int m = 0; m < 4; ++m) { bf16_t* rowp = base + (size_t)(row0 + ai * HALF + m * 16) * ldc + col0;
#pragma unroll
                for (int bj = 0; bj < 2; ++bj) { f32x4 v0 = acc[ai][bj][m][0] * sc, v1 = acc[ai][bj][m][1] * sc;
                    u32x4 w; w.x = cvt_pk_bf16(v0[0], v0[1]); w.y = cvt_pk_bf16(v0[2], v0[3]); w.z = cvt_pk_bf16(v1[0], v1[1]); w.w = cvt_pk_bf16(v1[2], v1[3]);
                    *(u32x4*)(rowp + bj * HALF) = w;
                    if (dok) { float s = 0.f;
#pragma unroll
                        for (int k = 0; k < 4; ++k) { const float a = __uint_as_float(w[k] << 16), b = __uint_as_float(w[k] & 0xffff0000u); s += a * a + b * b; }
                        s += __shfl_xor(s, 16); s += __shfl_xor(s, 32); mx[bj] = fmaxf(mx[bj], s); } } }
        if (dok) {
#pragma unroll
            for (int bj = 0; bj < 2; ++bj) { float s = mx[bj]; s = fmaxf(s, __shfl_xor(s, 1)); s = fmaxf(s, __shfl_xor(s, 2)); s = fmaxf(s, __shfl_xor(s, 4)); s = fmaxf(s, __shfl_xor(s, 8));
                if (fr == 0 && fq == 0) { const int cl = colt + bj * HALF + wc * 32; __hip_atomic_fetch_max(kmaxw + (((u.pm * BM) / rows_per_batch) * 16 + (cl >> 6)) * 16 + ((cl >> 5) & 1), __float_as_uint(s), __ATOMIC_RELAXED, __HIP_MEMORY_SCOPE_AGENT); } }
        }
    }
};
struct EpiResid {
    static constexpr bool PERM = true, AFTER_DRAIN = false;
    const float* Xin32; const unsigned short* Xin; unsigned short* Xout; const float* g; int gstride; int rows_per_batch; int ldc;
    __device__ __forceinline__ void operator()(const f32x4 (&acc)[2][2][4][2], const Unit& u, int wr, int wc, int fr, int fq) const {
        const int row0 = u.pm * BM + wr * 64 + fr, col0 = u.pn * BM + wc * 32 + 8 * fq;
        const int b = (u.pm * BM) / rows_per_batch;
        f32x4 gv[2][2];
#pragma unroll
        for (int bj = 0; bj < 2; ++bj)
#pragma unroll
            for (int n = 0; n < 2; ++n) gv[bj][n] = *(const f32x4*)(g + (size_t)b * gstride + col0 + bj * HALF + 4 * n);
        if (Xin32) {
#pragma unroll
            for (int ai = 0; ai < 2; ++ai)
#pragma unroll
                for (int m = 0; m < 4; ++m) { const size_t off = (size_t)(row0 + ai * HALF + m * 16) * ldc + col0;
#pragma unroll
                    for (int bj = 0; bj < 2; ++bj) { const f32x4 x0 = *(const f32x4*)(Xin32 + off + bj * HALF) + gv[bj][0] * acc[ai][bj][m][0], x1 = *(const f32x4*)(Xin32 + off + bj * HALF + 4) + gv[bj][1] * acc[ai][bj][m][1];
                        u32x4 w; w.x = cvt_pk_bf16(x0[0], x0[1]); w.y = cvt_pk_bf16(x0[2], x0[3]); w.z = cvt_pk_bf16(x1[0], x1[1]); w.w = cvt_pk_bf16(x1[2], x1[3]);
                        *(u32x4*)(Xout + off + bj * HALF) = w; } }
        } else {
#pragma unroll
            for (int ai = 0; ai < 2; ++ai)
#pragma unroll
                for (int m = 0; m < 4; ++m) { const size_t off = (size_t)(row0 + ai * HALF + m * 16) * ldc + col0;
#pragma unroll
                    for (int bj = 0; bj < 2; ++bj) { const u32x4 r = *(const u32x4*)(Xin + off + bj * HALF);
                        const f32x4 x0 = (f32x4){__uint_as_float(r.x << 16), __uint_as_float(r.x & 0xffff0000u), __uint_as_float(r.y << 16), __uint_as_float(r.y & 0xffff0000u)} + gv[bj][0] * acc[ai][bj][m][0];
                        const f32x4 x1 = (f32x4){__uint_as_float(r.z << 16), __uint_as_float(r.z & 0xffff0000u), __uint_as_float(r.w << 16), __uint_as_float(r.w & 0xffff0000u)} + gv[bj][1] * acc[ai][bj][m][1];
                        u32x4 w; w.x = cvt_pk_bf16(x0[0], x0[1]); w.y = cvt_pk_bf16(x0[2], x0[3]); w.z = cvt_pk_bf16(x1[0], x1[1]); w.w = cvt_pk_bf16(x1[2], x1[3]);
                        *(u32x4*)(Xout + off + bj * HALF) = w; } }
        }
    }
};
struct EpiSwiglu {
    static constexpr bool PERM = true, AFTER_DRAIN = false;
    unsigned char* ACT; const float* bgu;
    __device__ __forceinline__ void operator()(const f32x4 (&acc)[2][2][4][2], const Unit& u, int wr, int wc, int fr, int fq) const {
        const int e = u.pn >> 3, nt = u.pn & 7;
        const int row0 = u.pm * BM + wr * 64 + fr, j0 = nt * HALF + wc * 32 + 8 * fq;
        const float* bb = bgu + (size_t)e * 2048 + j0;
        f32x4 bg[2], bu[2];
#pragma unroll
        for (int n = 0; n < 2; ++n) { bg[n] = *(const f32x4*)(bb + 4 * n); bu[n] = *(const f32x4*)(bb + 1024 + 4 * n); }
        f32x2 bgp[4], bup[4];
#pragma unroll
        for (int n = 0; n < 2; ++n) { bgp[2 * n] = (f32x2){bg[n][0], bg[n][1]}; bgp[2 * n + 1] = (f32x2){bg[n][2], bg[n][3]}; bup[2 * n] = (f32x2){bu[n][0] + 1.0f, bu[n][1] + 1.0f}; bup[2 * n + 1] = (f32x2){bu[n][2] + 1.0f, bu[n][3] + 1.0f}; }
#pragma unroll
        for (int ai = 0; ai < 2; ++ai)
#pragma unroll
            for (int m = 0; m < 4; ++m) {
                f32x2 rr[4];
#pragma unroll
                for (int h = 0; h < 4; ++h) { const int n = h >> 1, k = (h & 1) * 2;
                    f32x2 g2 = (f32x2){acc[ai][0][m][n][k], acc[ai][0][m][n][k + 1]} * W8_INV + bgp[h];
                    f32x2 u2 = (f32x2){acc[ai][1][m][n][k], acc[ai][1][m][n][k + 1]} * W8_INV + bup[h];
                    g2.x = fminf(g2.x, 7.0f); g2.y = fminf(g2.y, 7.0f);
                    u2.x = __builtin_amdgcn_fmed3f(u2.x, -6.0f, 8.0f); u2.y = __builtin_amdgcn_fmed3f(u2.y, -6.0f, 8.0f);
                    const f32x2 t = g2 * (-1.702f * 1.4426950408889634f);
                    f32x2 e; e.x = __builtin_amdgcn_exp2f(t.x); e.y = __builtin_amdgcn_exp2f(t.y);
                    e = e + 1.0f;
                    f32x2 s; s.x = __builtin_amdgcn_rcpf(e.x); s.y = __builtin_amdgcn_rcpf(e.y);
                    rr[h] = (g2 * u2) * s; }
                u32x2 w; w.x = cvt_pk4_fp8(rr[0].x, rr[0].y, rr[1].x, rr[1].y); w.y = cvt_pk4_fp8(rr[2].x, rr[2].y, rr[3].x, rr[3].y);
                *(u32x2*)(ACT + (size_t)(row0 + ai * HALF + m * 16) * 1024 + j0) = w; }
    }
};
constexpr float YS_SCALE = 16.0f, YS_INV = 1.0f / 16.0f;
struct EpiDown {
    static constexpr bool PERM = true, AFTER_DRAIN = false;
    unsigned char* YS; const float* bd; const float* rgate;
    __device__ __forceinline__ void operator()(const f32x4 (&acc)[2][2][4][2], const Unit& u, int wr, int wc, int fr, int fq) const {
        const int e = u.pn >> 2, nt = u.pn & 3;
        const int row0 = u.pm * BM + wr * 64 + fr, col0 = nt * BM + wc * 32 + 8 * fq;
        f32x4 bv[2][2];
#pragma unroll
        for (int bj = 0; bj < 2; ++bj)
#pragma unroll
            for (int n = 0; n < 2; ++n) bv[bj][n] = *(const f32x4*)(bd + (size_t)e * 1024 + col0 + bj * HALF + 4 * n);
#pragma unroll
        for (int ai = 0; ai < 2; ++ai)
#pragma unroll
            for (int m = 0; m < 4; ++m) { const int row = row0 + ai * HALF + m * 16; const float gt = rgate[row] * YS_SCALE; unsigned char* rowp = YS + (size_t)row * 1024 + col0;
#pragma unroll
                for (int bj = 0; bj < 2; ++bj) { const f32x4 v0 = (acc[ai][bj][m][0] * W8_INV + bv[bj][0]) * gt, v1 = (acc[ai][bj][m][1] * W8_INV + bv[bj][1]) * gt;
                    u32x2 w; w.x = cvt_pk4_fp8(v0[0], v0[1], v0[2], v0[3]); w.y = cvt_pk4_fp8(v1[0], v1[1], v1[2], v1[3]);
                    *(u32x2*)(rowp + bj * HALF) = w; } }
    }
};
struct GroupedOrder {
    const PG8_LAS int* P; int nN, G, c, cap;
    __device__ __forceinline__ bool next(int i, Unit& u) const {
        int mt, nt;
        if (G == 256) { const int x = c & 7, j = c >> 3, mpx = 32 / nN; mt = i * (8 * mpx) + x * mpx + j / nN; nt = j % nN; }
        else { const long L = (long)i * G + c; mt = (int)(L / nN); nt = (int)(L % nN); }
        if (mt >= P[32]) return false;
        const int ln = (int)__builtin_amdgcn_mbcnt_hi(~0u, __builtin_amdgcn_mbcnt_lo(~0u, 0u)) & 31; const int pl_ = P[ln], pn_ = P[ln + 1];
        int e = (int)__builtin_ctzll(__ballot(pl_ <= mt && mt < pn_) | (1ull << 63)) & 31;
        e = __builtin_amdgcn_readfirstlane(e); u.pm = mt; u.pn = e * nN + nt; u.gl = e * cap + (mt - P[e]) * BM; u.gl = __builtin_amdgcn_readfirstlane(u.gl); return true;
    }
    __device__ __forceinline__ void a_ready(const Unit&) const {}
    __device__ __forceinline__ void done(const Unit&) const {}
};

template <class Epi, class Sched, bool ALIGN_EPI = false, bool SP2 = false, bool F8 = false, bool GATHER = false>
__device__ __forceinline__ void gemm_phase(PG8_LAS unsigned char* lds, const Gemm g, const Sched& S, const Epi& E, int wave_id, const int* rowlist = nullptr, PG8_LAS int* tokl = nullptr) {
    int tid_; asm volatile("v_mbcnt_lo_u32_b32 %0, -1, 0\n\tv_mbcnt_hi_u32_b32 %0, -1, %0\n\tv_lshl_add_u32 %0, %1, 6, %0" : "=&v"(tid_) : "s"(wave_id));
    const int tid = tid_, wid = __builtin_amdgcn_readfirstlane(tid >> 6), lane = tid & 63, wr = wid >> 2, wc = wid & 3, fr = lane & 15, fq = lane >> 4;
    static_assert(!GATHER || SP2, "the gathered-A path is written for the two-super-phase loop");
    const int K = g.K, nt = K / BK;
    unsigned voffA[2], voffB[2]; int rowA[2]; unsigned colA[2];
#pragma unroll
    for (int i = 0; i < 2; ++i) { int R, C; stage_rc(tid * 16 + i * 8192, R, C); const int Rb = Epi::PERM ? ((R & ~31) + perm32(R & 31)) : R;
        voffA[i] = (unsigned)(R * K + C) * 2u; voffB[i] = (unsigned)(Rb * K + C) * 2u; rowA[i] = R; colA[i] = (unsigned)C * 2u; }
    unsigned vG[2][2] = {{0u, 0u}, {0u, 0u}}, vGn[2][2] = {{0u, 0u}, {0u, 0u}};
#define PG8_TOKFETCH(u_, par_) do { if (wid < 4) { int ln_ = lane; asm volatile("" : "+v"(ln_));   \
        __builtin_amdgcn_global_load_lds((const unsigned*)(rowlist + (u_).gl + 64 * wid + ln_), (PG8_LAS unsigned*)(tokl + (par_) * 256 + 64 * wid), 4, 0, 0); } } while (0)
#define PG8_TOKREAD(dst_, par_) do { _Pragma("unroll") for (int h_ = 0; h_ < 2; ++h_) _Pragma("unroll") for (int i_ = 0; i_ < 2; ++i_) dst_[h_][i_] = (unsigned)(tokl[(par_) * 256 + h_ * HALF + rowA[i_]] & 0x7fff) * (unsigned)(K * 2) + colA[i_]; } while (0)
#define PG8_STAGE_A(bufoff, ptr, h_, nx_) do { if constexpr (GATHER) { unsigned vo_[2]; vo_[0] = (nx_) ? vGn[h_][0] : vG[h_][0]; vo_[1] = (nx_) ? vGn[h_][1] : vG[h_][1]; PG8_STAGE(bufoff, ptr, vo_); } \
        else { PG8_STAGE(bufoff, (ptr) + (h_) * hstep, voffA); } } while (0)
    const size_t kstep = (size_t)(BK * 2);
    const size_t hstep = (size_t)HALF * K * 2;
    const size_t tstep = 2 * hstep;
    const unsigned ldsw = (unsigned)wid * 1024u;
    const int aoff = lds_byte(wr * 64 + fr, fq * 8), boff = lds_byte(wc * 32 + fr, fq * 8);
#define PG8_SA(b, h) (((b) * 2 + (h)) * HTB)
#define PG8_SB(b, h) ((4 + (b) * 2 + (h)) * HTB)
#define PG8_STAGE(bufoff, gbase, voff) do { _Pragma("unroll") for (int _i = 0; _i < 2; ++_i) \
        __builtin_amdgcn_global_load_lds((const unsigned*)((const char*)(gbase) + (voff)[_i]), (PG8_LAS unsigned*)(lds + (bufoff) + ldsw + _i * 8192), 16, 0, 0); } while (0)
#define PG8_LDA(dst, b, h) do { _Pragma("unroll") for (int m = 0; m < 4; ++m) _Pragma("unroll") for (int k = 0; k < 2; ++k) dst[m][k] = *(const PG8_LAS bf16x8*)(lds + PG8_SA(b, h) + aoff + m * 2048 + k * 1024); } while (0)
#define PG8_LDB(dst, b, h) do { _Pragma("unroll") for (int n = 0; n < 2; ++n) _Pragma("unroll") for (int k = 0; k < 2; ++k) dst[n][k] = *(const PG8_LAS bf16x8*)(lds + PG8_SB(b, h) + boff + n * 2048 + k * 1024); } while (0)
#define PG8_CAT(x0, x1) __builtin_shufflevector(__builtin_bit_cast(v4i_t, x0), __builtin_bit_cast(v4i_t, x1), 0, 1, 2, 3, 4, 5, 6, 7)
#define PG8_MMA(ai, bj, At, Bt) do { __builtin_amdgcn_s_setprio(1); _Pragma("unroll") for (int m = 0; m < 4; ++m) _Pragma("unroll") for (int n = 0; n < 2; ++n) { \
        if constexpr (F8) asm volatile("v_mfma_scale_f32_16x16x128_f8f6f4 %0, %1, %2, %0, %3, %3 op_sel_hi:[0,0,0]" : "+v"(acc[ai][bj][m][n]) : "v"(PG8_CAT(Bt[n][0], Bt[n][1])), "v"(PG8_CAT(At[m][0], At[m][1])), "v"(f8scale)); \
        else { _Pragma("unroll") for (int k = 0; k < 2; ++k) acc[ai][bj][m][n] = __builtin_amdgcn_mfma_f32_16x16x32_bf16(Bt[n][k], At[m][k], acc[ai][bj][m][n], 0, 0, 0); } } __builtin_amdgcn_s_setprio(0); } while (0)
#define PG8_WAIT_V(n) asm volatile("s_waitcnt vmcnt(" #n ")" ::: "memory")
#define PG8_WAIT_L(n) asm volatile("s_waitcnt lgkmcnt(" #n ")" ::: "memory")
#define PG8_BAR __builtin_amdgcn_s_barrier()
#define PG8_SCHED __builtin_amdgcn_sched_barrier(0)
    const int f8scale = 0x7F7F7F7F;
    Unit cur, nxt; int ui = 0;
    if (!S.next(0, cur)) return;
    f32x4 acc[2][2][4][2];
#pragma unroll
    for (int a = 0; a < 2; ++a)
#pragma unroll
        for (int b = 0; b < 2; ++b)
#pragma unroll
            for (int m = 0; m < 4; ++m)
#pragma unroll
                for (int n = 0; n < 2; ++n) acc[a][b][m][n] = (f32x4){0.f, 0.f, 0.f, 0.f};
    bf16x8 At[4][2], B0[2][2], B1[2][2];
    const char* cA = GATHER ? (const char*)g.A : (const char*)g.A + (size_t)cur.pm * tstep; const char* cB = (const char*)g.Bt + (size_t)cur.pn * tstep;
    S.a_ready(cur);
    if constexpr (GATHER) { PG8_TOKFETCH(cur, 0); asm volatile("s_waitcnt vmcnt(0)" ::: "memory"); __builtin_amdgcn_s_barrier(); PG8_TOKREAD(vG, 0); asm volatile("s_waitcnt lgkmcnt(0)" ::: "memory"); }
    if constexpr (SP2) {
        PG8_STAGE(PG8_SB(0, 0), cB, voffB); PG8_STAGE(PG8_SB(0, 1), cB + hstep, voffB); PG8_STAGE_A(PG8_SA(0, 0), cA, 0, false); PG8_STAGE_A(PG8_SA(0, 1), cA, 1, false);
        if (wr == 1) PG8_BAR;
        PG8_WAIT_V(2); PG8_BAR;
        PG8_STAGE(PG8_SB(1, 0), cB + kstep, voffB); PG8_STAGE_A(PG8_SA(1, 0), cA + kstep, 0, false); PG8_STAGE(PG8_SB(1, 1), cB + hstep + kstep, voffB);
        PG8_WAIT_V(6); PG8_BAR;
    } else {
        PG8_STAGE(PG8_SB(0, 0), cB, voffB); PG8_STAGE(PG8_SA(0, 0), cA, voffA); PG8_STAGE(PG8_SB(0, 1), cB + hstep, voffB); PG8_STAGE(PG8_SA(0, 1), cA + hstep, voffA);
        if (wr == 1) PG8_BAR;
        PG8_WAIT_V(4); PG8_BAR;
        PG8_STAGE(PG8_SB(1, 0), cB + kstep, voffB); PG8_STAGE(PG8_SA(1, 0), cA + kstep, voffA); PG8_STAGE(PG8_SB(1, 1), cB + hstep + kstep, voffB);
        PG8_WAIT_V(6); PG8_BAR;
    }
    for (;;) {
        const bool has_next = S.next(ui + 1, nxt);
        const char* nA = GATHER ? cA : (has_next ? (const char*)g.A + (size_t)nxt.pm * tstep : cA); const char* nB = has_next ? (const char*)g.Bt + (size_t)nxt.pn * tstep : cB;
        if constexpr (GATHER) { if (has_next) PG8_TOKFETCH(nxt, (ui + 1) & 1); }
#pragma unroll 1
        for (int t = 0; t < nt; t += 2) {
            const bool last = (t == nt - 2);
            const char* a1 = cA + (size_t)(t + 1) * kstep;
            const char* a2 = last ? nA : cA + (size_t)(t + 2) * kstep; const char* b2 = last ? nB : cB + (size_t)(t + 2) * kstep;
            const char* a3 = a2 + kstep; const char* b3 = b2 + kstep;
            if (last && has_next) S.a_ready(nxt);
            if constexpr (GATHER) { if (last) { if (has_next) { PG8_TOKREAD(vGn, (ui + 1) & 1); } else { vGn[0][0] = vG[0][0]; vGn[0][1] = vG[0][1]; vGn[1][0] = vG[1][0]; vGn[1][1] = vG[1][1]; } } }
            if constexpr (SP2) {
            PG8_LDB(B0, 0, 0); PG8_LDB(B1, 0, 1); PG8_SCHED; PG8_LDA(At, 0, 0); PG8_STAGE_A(PG8_SA(1, 1), a1, 1, false);
            PG8_WAIT_V(8); PG8_WAIT_L(0); PG8_BAR; PG8_MMA(0, 0, At, B0); PG8_MMA(0, 1, At, B1); PG8_BAR; PG8_SCHED;
            PG8_LDA(At, 0, 1); PG8_STAGE(PG8_SB(0, 0), b2, voffB); PG8_STAGE(PG8_SB(0, 1), b2 + hstep, voffB); PG8_STAGE_A(PG8_SA(0, 0), a2, 0, last);
            PG8_WAIT_V(8); PG8_WAIT_L(0); PG8_BAR; PG8_MMA(1, 0, At, B0); PG8_MMA(1, 1, At, B1); PG8_BAR; PG8_SCHED;
            PG8_LDB(B0, 1, 0); PG8_LDB(B1, 1, 1); PG8_SCHED; PG8_LDA(At, 1, 0); PG8_STAGE_A(PG8_SA(0, 1), a2, 1, last);
            PG8_WAIT_V(8); PG8_WAIT_L(0); PG8_BAR; PG8_MMA(0, 0, At, B0); PG8_MMA(0, 1, At, B1); PG8_BAR; PG8_SCHED;
            PG8_LDA(At, 1, 1); PG8_STAGE(PG8_SB(1, 0), b3, voffB); PG8_STAGE(PG8_SB(1, 1), b3 + hstep, voffB); PG8_STAGE_A(PG8_SA(1, 0), a3, 0, last);
            PG8_WAIT_V(8); PG8_WAIT_L(0); PG8_BAR; PG8_MMA(1, 0, At, B0); PG8_MMA(1, 1, At, B1); PG8_BAR; PG8_SCHED;
            } else {
            PG8_LDB(B0, 0, 0); PG8_SCHED; PG8_LDA(At, 0, 0); PG8_STAGE(PG8_SA(1, 1), a1 + hstep, voffA);
            PG8_WAIT_L(8); PG8_BAR; PG8_WAIT_L(0); PG8_MMA(0, 0, At, B0); PG8_BAR; PG8_SCHED;
            PG8_LDB(B1, 0, 1); PG8_STAGE(PG8_SB(0, 0), b2, voffB);
            PG8_BAR; PG8_WAIT_L(0); PG8_MMA(0, 1, At, B1); PG8_BAR;
            PG8_LDA(At, 0, 1); PG8_STAGE(PG8_SA(0, 0), a2, voffA);
            PG8_BAR; PG8_WAIT_L(0); PG8_MMA(1, 0, At, B0); PG8_BAR; PG8_SCHED;
            PG8_STAGE(PG8_SB(0, 1), b2 + hstep, voffB);
            PG8_WAIT_V(6); PG8_BAR; PG8_MMA(1, 1, At, B1); PG8_BAR;
            PG8_LDB(B0, 1, 0); PG8_SCHED; PG8_LDA(At, 1, 0); PG8_STAGE(PG8_SA(0, 1), a2 + hstep, voffA);
            PG8_WAIT_L(8); PG8_BAR; PG8_WAIT_L(0); PG8_MMA(0, 0, At, B0); PG8_BAR; PG8_SCHED;
            PG8_LDB(B1, 1, 1); PG8_STAGE(PG8_SB(1, 0), b3, voffB);
            PG8_BAR; PG8_WAIT_L(0); PG8_MMA(0, 1, At, B1); PG8_BAR;
            PG8_LDA(At, 1, 1); PG8_STAGE(PG8_SA(1, 0), a3, voffA);
            PG8_BAR; PG8_WAIT_L(0); PG8_MMA(1, 0, At, B0); PG8_BAR; PG8_SCHED;
            PG8_STAGE(PG8_SB(1, 1), b3 + hstep, voffB);
            PG8_WAIT_V(6); PG8_BAR; PG8_MMA(1, 1, At, B1); PG8_BAR;
            }
        }
        if constexpr (ALIGN_EPI) { if (wr == 0) PG8_BAR; }
        if constexpr (F8) asm volatile("s_nop 15\n\ts_nop 15" ::: "memory");
        if constexpr (!Epi::AFTER_DRAIN) { int fr_ = fr, fq_ = fq; asm volatile("" : "+v"(fr_), "+v"(fq_));
            E(acc, cur, wr, wc, fr_, fq_); S.done(cur); }
        if (!has_next) break;
#pragma unroll
        for (int a = 0; a < 2; ++a)
#pragma unroll
            for (int b = 0; b < 2; ++b)
#pragma unroll
                for (int m = 0; m < 4; ++m)
#pragma unroll
                    for (int n = 0; n < 2; ++n) acc[a][b][m][n] = (f32x4){0.f, 0.f, 0.f, 0.f};
        cur = nxt; cA = nA; cB = nB; ++ui;
        if constexpr (GATHER) { vG[0][0] = vGn[0][0]; vG[0][1] = vGn[0][1]; vG[1][0] = vGn[1][0]; vG[1][1] = vGn[1][1]; }
        if constexpr (ALIGN_EPI) { if (wr == 1) PG8_BAR; }
    }
    PG8_WAIT_V(0);
    if constexpr (!ALIGN_EPI) { if (wr == 0) PG8_BAR; }
    PG8_BAR;
    if constexpr (Epi::AFTER_DRAIN) { E.fused(acc, cur, wr, wc, fr, fq, lds, wid, lane); S.done(cur); }
#undef PG8_SA
#undef PG8_SB
#undef PG8_STAGE
#undef PG8_STAGE_A
#undef PG8_TOKFETCH
#undef PG8_TOKREAD
#undef PG8_LDA
#undef PG8_LDB
#undef PG8_MMA
#undef PG8_CAT
#undef PG8_WAIT_V
#undef PG8_WAIT_L
#undef PG8_BAR
#undef PG8_SCHED
}
}


#define GAS __attribute__((address_space(1)))
#define LAS __attribute__((address_space(3)))
typedef unsigned short bf16;
typedef unsigned v4u __attribute__((ext_vector_type(4)));
typedef unsigned v2u __attribute__((ext_vector_type(2)));
typedef unsigned u32x4 __attribute__((ext_vector_type(4)));
typedef float f32x4 __attribute__((ext_vector_type(4)));
typedef float f32x16 __attribute__((ext_vector_type(16)));
typedef short bf16x8 __attribute__((ext_vector_type(8)));
typedef short s16x4 __attribute__((ext_vector_type(4)));
typedef GAS unsigned gu32;
#define RLX_AGENT __ATOMIC_RELAXED, __HIP_MEMORY_SCOPE_AGENT
#define LDS_WAIT() asm volatile("s_waitcnt lgkmcnt(0)" ::: "memory")
#define VM_WAIT() asm volatile("s_waitcnt vmcnt(0)" ::: "memory")
__device__ __forceinline__ unsigned pk2(float lo, float hi) { unsigned r; asm volatile("v_cvt_pk_bf16_f32 %0, %1, %2" : "=v"(r) : "v"(lo), "v"(hi)); return r; }
__device__ __forceinline__ unsigned pk4f8(float a, float b, float c, float d) { int r = __builtin_amdgcn_cvt_pk_fp8_f32(a, b, 0, false); r = __builtin_amdgcn_cvt_pk_fp8_f32(c, d, r, true); return (unsigned)r; }
typedef float f32x2g __attribute__((ext_vector_type(2)));
__device__ __forceinline__ f32x4 f8x4_to_f32(unsigned w) { const f32x2g lo = __builtin_amdgcn_cvt_pk_f32_fp8((int)w, false), hi = __builtin_amdgcn_cvt_pk_f32_fp8((int)w, true); return (f32x4){lo.x, lo.y, hi.x, hi.y}; }
__device__ __forceinline__ float bflo(unsigned w) { return __uint_as_float(w << 16); }
__device__ __forceinline__ float bfhi(unsigned w) { return __uint_as_float(w & 0xffff0000u); }
__device__ __forceinline__ float half_sum32(float v) {
#define WS_DPP(x_, c_) __int_as_float(__builtin_amdgcn_update_dpp(0, __float_as_int(x_), (c_), 0xf, 0xf, false))
    v += WS_DPP(v, 0xB1); v += WS_DPP(v, 0x4E); v += WS_DPP(v, 0x141); v += WS_DPP(v, 0x140);
#undef WS_DPP
    v += __int_as_float(__builtin_amdgcn_ds_swizzle(__float_as_int(v), 0x401F));
    return v;
}
__device__ __forceinline__ float wave_sum(float v) {
    v = half_sum32(v);
    auto rr = __builtin_amdgcn_permlane32_swap(__float_as_uint(v), __float_as_uint(v), false, false);
    return __uint_as_float(rr[0]) + __uint_as_float(rr[1]);
}

constexpr int BATCH = 4, SEQ = 8192, D = 1024, T = BATCH * SEQ, DEPTH = 4, NE = 32, TOPK = 4;
constexpr int XG_ROWS = T * TOPK + NE * 256;
constexpr float EPS = 1e-6f, LOG2E = 1.4426950408889634f;
constexpr float QSCALE = 0.125f * LOG2E;
constexpr int NWAVES = 8;

constexpr size_t MiB = 1u << 20;
constexpr size_t WS_CTL = 0, CTL_ZERO_BYTES = 128 * 1024;
constexpr size_t WS_MOD = 2 * MiB;
constexpr size_t WS_KVMOD = WS_MOD + (size_t)DEPTH * BATCH * 6 * D * 4;
constexpr size_t WS_SLOT_E = 3 * MiB, WS_SLOT_POS = WS_SLOT_E + (size_t)T * 16, WS_SLOT_GATE = WS_SLOT_POS + (size_t)T * 16, WS_SLOT_ROW = WS_SLOT_GATE + (size_t)T * 16, WS_RGATE = WS_SLOT_ROW + (size_t)T * 16;
static_assert(WS_RGATE + (size_t)XG_ROWS * 4 <= 8 * MiB, "routing tables");
constexpr int TOK_CAP = T + 256;
constexpr size_t WS_WQKV = 8 * MiB;
constexpr size_t WS_WOA = WS_WQKV + 12 * MiB;
constexpr size_t WS_WKV = WS_WOA + 4 * MiB;
constexpr size_t WS_WQB = WS_WKV + 4 * MiB;
constexpr size_t WS_WOB = WS_WQB + 4 * MiB;
constexpr size_t WS_WGU = WS_WOB + 4 * MiB;
constexpr size_t WS_WD = WS_WGU + 256 * MiB;
constexpr size_t WS_XCUR = WS_WD + 128 * MiB;
constexpr size_t WS_H = WS_XCUR + 128 * MiB;
constexpr size_t WS_HKV = WS_H + 64 * MiB;
constexpr size_t WS_Q = WS_HKV + 64 * MiB, WS_K = WS_Q + 64 * MiB, WS_V = WS_K + 64 * MiB;
constexpr size_t WS_KSH = WS_V + 64 * MiB, WS_VSH = WS_KSH + 64 * MiB;
constexpr size_t WS_O0 = WS_VSH + 64 * MiB, WS_O1 = WS_O0 + 64 * MiB, WS_OC = WS_O1 + 64 * MiB;
constexpr size_t WS_XG = WS_OC + 64 * MiB;
constexpr size_t WS_ACT = WS_XG + 136 * MiB;
constexpr size_t WS_YS = WS_ACT + 136 * MiB;
constexpr int MODN = DEPTH * BATCH * 6 * D + BATCH * 2 * D, MODS = 8;
constexpr size_t WS_MODP = WS_YS + 136 * MiB, WS_END = WS_MODP + 4 * MiB;
static_assert((size_t)MODS * MODN * 4 <= 4 * MiB, "modp");
static_assert((size_t)XG_ROWS * D <= 136 * MiB, "XG");
constexpr int CW_BAR = 4096;
constexpr int CW_CNT = 16384;
constexpr int CW_XRANK = 7680;
constexpr int CW_AQ = 8192;
constexpr int CW_KMAX = CW_CNT + DEPTH * NE * 64;
static_assert((CW_KMAX + 2 * BATCH * 16 * 16) * 4 <= (int)CTL_ZERO_BYTES, "CTL words inside the memset region");

constexpr int RING_OFF = 0, RING_BYTES = 131072;
constexpr int MISC_OFF = RING_BYTES;
constexpr int TAB_OFF = MISC_OFF + 1024;
constexpr int LDS_BYTES = 155648;

#define XB_TMO      128
#define XB_XCNT(j)  (256  + 64 * (j))
#define XB_XSUB(j)  (1280 + 64 * (j))
#define XB_XGEN(j)  (2304 + 64 * (j))
#define XB_TOP      3328
#define XB_TOPGEN   3392
#define XCD_BAR_WORDS 3456
#define XB_SPIN_CAP (1u << 18)

__device__ __forceinline__ unsigned xb_ld(unsigned* p)              { return __hip_atomic_load(p, __ATOMIC_RELAXED, __HIP_MEMORY_SCOPE_AGENT); }
__device__ __forceinline__ unsigned xb_add(unsigned* p, unsigned v) { return __hip_atomic_fetch_add(p, v, __ATOMIC_RELAXED, __HIP_MEMORY_SCOPE_AGENT); }
__device__ __forceinline__ unsigned xb_xcc_id() { return (unsigned)__builtin_amdgcn_s_getreg((3 << 11) | 20) & 0xFu; }
#define XB_SPIN(cond, bar) do { unsigned _sp = 0; while (cond) { __builtin_amdgcn_s_sleep(1); \
    if ((++_sp & 255u) == 0u) { if (xb_ld(&(bar)[XB_TMO])) break; if (_sp > XB_SPIN_CAP) { atomicAdd(&(bar)[XB_TMO], 1u); break; } } } } while (0)

struct XcdBarrier {
    unsigned* bar; unsigned x;
    volatile LAS unsigned* st;
};

__device__ __forceinline__ XcdBarrier xcd_barrier_post(unsigned* bar, volatile LAS unsigned* st) {
    XcdBarrier b; b.bar = bar; b.x = xb_xcc_id(); b.st = st;
    if (threadIdx.x == 0) (void)xb_add(&bar[XB_XCNT(b.x)], 1u);
    return b;
}
__device__ __forceinline__ void xcd_barrier_complete(unsigned* bar, unsigned x, unsigned& nloc, unsigned& nx) {
    const unsigned G = gridDim.x * gridDim.y * gridDim.z;
    unsigned sum, cnt, mine, sp = 0u;
    for (;;) {
        sum = 0u; cnt = 0u; mine = 0u;
#pragma unroll
        for (unsigned j = 0; j < 16; ++j) { const unsigned c = xb_ld(&bar[XB_XCNT(j)]); sum += c; cnt += (c > 0u) ? 1u : 0u; mine = (j == x) ? c : mine; }
        if (sum == G) break;
        __builtin_amdgcn_s_sleep(1);
        if ((++sp & 255u) == 0u) { if (xb_ld(&bar[XB_TMO])) break; if (sp > XB_SPIN_CAP) { atomicAdd(&bar[XB_TMO], 1u); break; } }
    }
    nloc = mine > 0u ? mine : 1u; nx = cnt > 0u ? cnt : 1u;
}

__device__ __forceinline__ void xcd_barrier(const XcdBarrier& b) {
    asm volatile("s_waitcnt vmcnt(0)" ::: "memory");
    __syncthreads();
    if (threadIdx.x == 0) {
        unsigned* bar = b.bar;
        __builtin_amdgcn_s_waitcnt(0);
        unsigned nloc = b.st[0], nx = b.st[1];
        if (nloc == 0u) { xcd_barrier_complete(bar, b.x, nloc, nx); b.st[0] = nloc; b.st[1] = nx; }
        const unsigned old = xb_add(&bar[XB_XSUB(b.x)], 1u);
        const unsigned gen = old / nloc;
        if (old + 1u == (gen + 1u) * nloc) {
            __builtin_amdgcn_fence(__ATOMIC_RELEASE, "agent");
            asm volatile("s_waitcnt vmcnt(0)" ::: "memory");
            const unsigned og = xb_add(&bar[XB_TOP], 1u);
            const unsigned tg = og / nx;
            if (og + 1u == (tg + 1u) * nx) xb_add(&bar[XB_TOPGEN], 1u);
            else XB_SPIN(xb_ld(&bar[XB_TOPGEN]) == tg, bar);
            __builtin_amdgcn_fence(__ATOMIC_ACQUIRE, "agent");
            xb_add(&bar[XB_XGEN(b.x)], 1u);
            asm volatile("s_waitcnt vmcnt(0)" ::: "memory");
        } else {
            XB_SPIN(xb_ld(&bar[XB_XGEN(b.x)]) == gen, bar);
            __builtin_amdgcn_fence(__ATOMIC_ACQUIRE, "agent");
            asm volatile("s_waitcnt vmcnt(0)" ::: "memory");
        }
    }
    __syncthreads();
}


namespace att {
constexpr int PITCH = 1024;
constexpr int L_K = 0, L_V = 16384, L_WS = 49152, L_FLAG = 51200, L_OST = 53248, L_END = L_OST + 65536;
static_assert(L_END <= 131072, "attention LDS");
typedef __attribute__((address_space(3))) const char* lds_cptr;
typedef short v4i16_t __attribute__((ext_vector_type(4)));
__device__ __forceinline__ int crow(int r, int hi) { return (r & 3) + 8 * (r >> 2) + 4 * hi; }
__device__ __forceinline__ void glds16(const void* gsrc, unsigned lds_dst) { unsigned keep;
    asm volatile("s_mov_b32 %0, m0\n\ts_mov_b32 m0, %2\n\ts_nop 0\n\tglobal_load_lds_dwordx4 %1, off\n\ts_mov_b32 m0, %0" : "=&s"(keep) : "v"(gsrc), "s"(lds_dst) : "memory"); }
__device__ __forceinline__ s16x4 vtr(lds_cptr p) { return __builtin_bit_cast(s16x4, __builtin_amdgcn_ds_read_tr16_b64_v4i16((__attribute__((address_space(3))) v4i16_t*)p)); }
#define ATT_WAIT_BAR() asm volatile("s_waitcnt vmcnt(0) lgkmcnt(0)\n\ts_barrier" ::: "memory")
__device__ __forceinline__ float min0f(float a) { float r; asm("v_min_f32_e32 %0, 0, %1" : "=v"(r) : "v"(a)); return r; }
__device__ __forceinline__ float max3f(float a, float b, float c) { float r; asm("v_max3_f32 %0, %1, %2, %3" : "=v"(r) : "v"(a), "v"(b), "v"(c)); return r; }
typedef float f32x2 __attribute__((ext_vector_type(2)));
__device__ __forceinline__ float swap_add(float v) { auto rr = __builtin_amdgcn_permlane32_swap(__float_as_uint(v), __float_as_uint(v), false, false); return __uint_as_float(rr[0]) + __uint_as_float(rr[1]); }
__device__ __forceinline__ float swap_max(float v) { auto rr = __builtin_amdgcn_permlane32_swap(__float_as_uint(v), __float_as_uint(v), false, false); return fmaxf(__uint_as_float(rr[0]), __uint_as_float(rr[1])); }

struct Tensors { const bf16* Q; const bf16* K; const bf16* V; bf16* O; };

template <int MODE, bool EARLY, int VAR = 0>
__device__ __forceinline__ void attn_unit(const Tensors& Tn, int b, int qcol, int kcol, int vcol, int ocol, int qb, float s2, float kmax, int upar, int wave_id, LAS char* shm, int rpass = -1, float lam = 0.f, const float* gsub = nullptr) {
    constexpr int DV = (MODE == 0) ? 128 : 64, NDB = DV / 32, NVP = NDB / 2;
    constexpr float THR = 8.0f;
    int tid_; asm volatile("v_mbcnt_lo_u32_b32 %0, -1, 0\n\tv_mbcnt_hi_u32_b32 %0, -1, %0\n\tv_lshl_add_u32 %0, %1, 6, %0" : "=&v"(tid_) : "s"(wave_id));
    const int tid = tid_, lane = tid & 63, r32 = lane & 31, hi = lane >> 5; const int wid = __builtin_amdgcn_readfirstlane(tid >> 6);
    const long rowbase = (long)b * SEQ; const int q0 = qb * 256;
    const bf16* Qw = Tn.Q + (rowbase + q0 + wid * 32) * PITCH + qcol;
    const bf16* Kh = Tn.K + rowbase * PITCH + kcol; const bf16* Vh = Tn.V + rowbase * PITCH + vcol;
    const unsigned lds0 = (unsigned)(uintptr_t)shm;
    LAS float* wsf = (LAS float*)(shm + L_WS) + wid * 64;
    volatile LAS unsigned* flags = (volatile LAS unsigned*)(shm + L_FLAG + (upar & 1) * 32);
    const lds_cptr shm3 = (lds_cptr)shm;
    const bf16* ksrc = Kh + (long)lane * PITCH + wid * 8;
    const unsigned kdst = lds0 + L_K + wid * 1024;
    const bf16* vsrc[NVP]; unsigned vdst[NVP];
#pragma unroll
    for (int i = 0; i < NVP; ++i) { const int p = wid + 8 * i; vsrc[i] = Vh + (long)(16 * (p & 3) + (lane >> 2)) * PITCH + (p >> 2) * 32 + (lane & 3) * 8; vdst[i] = lds0 + L_V + p * 1024; }
    const int NT = 4 * (qb + 1);
    bf16x8 qr[4];
#pragma unroll
    for (int d0 = 0; d0 < 4; ++d0) qr[d0] = *reinterpret_cast<const bf16x8*>(&Qw[(long)r32 * PITCH + d0 * 16 + hi * 8]);
    float ubqk = 0.f;
    if (MODE == 0 && EARLY) { float sq = 0.f;
#pragma unroll
        for (int d0 = 0; d0 < 4; ++d0)
#pragma unroll
            for (int k = 0; k < 8; ++k) { const float x = __uint_as_float(((unsigned)(unsigned short)qr[d0][k]) << 16); sq += x * x; }
        sq = swap_add(sq); ubqk = sqrtf(sq) * kmax * 1.01f + 0.25f; }
    f32x16 o[NDB];
#pragma unroll
    for (int d = 0; d < NDB; ++d) o[d] = f32x16{};
    float mref = 0.f, lsum = 0.f, R = 0.f; bool started = false, wdone = false;
    f32x16 bv = f32x16{};
    u32x4 akb0 = u32x4{}, akb1 = u32x4{}; unsigned s2w = 0u;
    if (MODE == 0) { const float off = (float)r32; const unsigned s2h = pk2(s2, 0.f) & 0xffffu; const float s2l = s2 - __uint_as_float(s2h << 16);
        if (hi == 0) { akb0.x = pk2(off, off); akb1.x = pk2(off + 32.0f, off + 32.0f); akb0.y = 0x3F803F80u; akb1.y = 0x3F803F80u; s2w = s2h | (pk2(s2l, 0.f) << 16); } }
    bf16x8 Mp0 = bf16x8{}, Mp1 = bf16x8{};
    if (MODE == 0) {
#pragma unroll
        for (int r = 0; r < 16; ++r) bv[r] = 0.f;
    } else {
#pragma unroll
        for (int j = 0; j < 8; ++j) { const int kvl = 4 * hi + (j & 3) + 8 * (j >> 2); Mp0[j] = (kvl > r32) ? (short)0x3F80 : (short)0; Mp1[j] = (16 + kvl > r32) ? (short)0x3F80 : (short)0; }
    }
    if (EARLY && wid == 0 && lane == 0) flags[0] = 0u;
#define ATT_ISSUE(jt_, slot_) do { glds16(ksrc + (long)(jt_) * 64 * PITCH, (unsigned)__builtin_amdgcn_readfirstlane(kdst + (slot_) * 8192)); \
        _Pragma("unroll") for (int i_ = 0; i_ < NVP; ++i_) glds16(vsrc[i_] + (long)(jt_) * 64 * PITCH, (unsigned)__builtin_amdgcn_readfirstlane(vdst[i_] + (slot_) * 16384)); } while (0)
    ATT_ISSUE(NT - 1, 0);
    ATT_WAIT_BAR();
    const int qlo = q0 + 32 * wid;
    for (int it = 0; it < NT; ++it) {
        const int jt = NT - 1 - it, cur = it & 1;
        if (it + 1 < NT) ATT_ISSUE(jt - 1, cur ^ 1);
        const bool active = (64 * jt <= qlo + 31) && !wdone;
        if (active) {
            const lds_cptr kp = shm3 + L_K + cur * 8192 + hi * 1024 + r32 * 16;
            const lds_cptr vp = shm3 + L_V + cur * 16384 + ((lane >> 4) & 1) * 32 + (lane & 3) * 8 + (4 * hi + ((lane & 15) >> 2)) * 64;
            const int qrel = qlo + r32 - 64 * jt;
            const bool band = (64 * jt + 63 >= qlo);
            f32x16 p0, p1;
            if (MODE == 0) {
                const float tb = s2 * (float)(64 * jt - q0);
                const float uu = tb - mref;
                const unsigned uh = pk2(uu, 0.f) & 0xffffu; const float ul = uu - __uint_as_float(uh << 16);
                u32x4 bq = u32x4{}; bq.x = s2w; bq.y = (hi == 0) ? (uh | (pk2(ul, 0.f) << 16)) : 0u;
                p0 = __builtin_amdgcn_mfma_f32_32x32x16_bf16(__builtin_bit_cast(bf16x8, akb0), __builtin_bit_cast(bf16x8, bq), f32x16{}, 0, 0, 0);
                p1 = __builtin_amdgcn_mfma_f32_32x32x16_bf16(__builtin_bit_cast(bf16x8, akb1), __builtin_bit_cast(bf16x8, bq), f32x16{}, 0, 0, 0);
            } else { p0 = f32x16{}; p1 = f32x16{}; }
#pragma unroll
            for (int d0 = 0; d0 < 4; ++d0) {
                const bf16x8 b0 = *(const __attribute__((address_space(3))) bf16x8*)(kp + d0 * 2048);
                const bf16x8 b1 = *(const __attribute__((address_space(3))) bf16x8*)(kp + d0 * 2048 + 512);
                p0 = __builtin_amdgcn_mfma_f32_32x32x16_bf16(b0, qr[d0], p0, 0, 0, 0);
                p1 = __builtin_amdgcn_mfma_f32_32x32x16_bf16(b1, qr[d0], p1, 0, 0, 0);
            }
            s16x4 vlo[NDB * 4], vhh[NDB * 4];
#pragma unroll
            for (int i = 0; i < 8; ++i) { vlo[i] = vtr(vp + (i >> 2) * 4096 + (i & 3) * 1024); vhh[i] = vtr(vp + (i >> 2) * 4096 + (i & 3) * 1024 + 512); }
            __builtin_amdgcn_sched_barrier(0);
            u32x4 pw0, pw1, pw2, pw3;
            if (MODE == 0) {
                if (band) {
#pragma unroll
                    for (int r = 0; r < 16; ++r) { const int kv = crow(r, hi); if (kv > qrel) p0[r] = -INFINITY; if (kv + 32 > qrel) p1[r] = -INFINITY; }
                }
                const bool need_ref = !started || !EARLY || __any(ubqk + s2 * (float)(64 * jt + 63 - q0) - mref > 40.0f);
                if (need_ref) {
                const float touch = __uint_as_float(((__float_as_uint(p0[15]) | __float_as_uint(p1[15])) & ((unsigned)upar >> 31)) | 0xff800000u);
                float rm = max3f(touch, p0[0], p1[0]), rm2 = max3f(touch, p0[1], p1[1]);
#pragma unroll
                for (int r = 2; r < 16; r += 2) { rm = max3f(rm, p0[r], p1[r]); rm2 = max3f(rm2, p0[r + 1], p1[r + 1]); }
                rm = max3f(rm, rm2, rm2);
                rm = swap_max(rm);
                if (!started) {
                    mref = rm;
#pragma unroll
                    for (int r = 0; r < 16; ++r) { p0[r] -= rm; p1[r] -= rm; }
                    started = true;
                } else if (__any(rm > THR)) {
                    const float dl = fmaxf(rm, 0.f); mref += dl;
#pragma unroll
                    for (int r = 0; r < 16; ++r) { p0[r] -= dl; p1[r] -= dl; }
                    const float f = __builtin_amdgcn_exp2f(-dl); lsum *= f;
                    if (hi == 0) wsf[r32] = f;
                    LDS_WAIT();
#pragma unroll
                    for (int r = 0; r < 16; ++r) { const float fr_ = wsf[crow(r, hi)];
#pragma unroll
                        for (int d = 0; d < NDB; ++d) o[d][r] *= fr_; }
                }
                }
#pragma unroll
                for (int r = 0; r < 16; ++r) { p0[r] = __builtin_amdgcn_exp2f(p0[r]); p1[r] = __builtin_amdgcn_exp2f(p1[r]); }
                f32x2 sa = (f32x2){p0[0], p0[1]} + (f32x2){p1[0], p1[1]}, sb = (f32x2){p0[2], p0[3]} + (f32x2){p1[2], p1[3]};
#pragma unroll
                for (int r = 4; r < 16; r += 4) { sa += (f32x2){p0[r], p0[r + 1]} + (f32x2){p1[r], p1[r + 1]}; sb += (f32x2){p0[r + 2], p0[r + 3]} + (f32x2){p1[r + 2], p1[r + 3]}; }
                sa += sb; lsum += sa.x + sa.y;
                if (EARLY) { if (__all(ubqk + s2 * (float)(64 * jt - 1 - q0) - mref < -40.0f)) { wdone = true; if (lane == 0) __hip_atomic_fetch_add((LAS unsigned*)&flags[0], 1u, __ATOMIC_RELAXED, __HIP_MEMORY_SCOPE_WORKGROUP); } }
            } else {
                f32x16 l0v, l1v; float rs0, rs1;
                {
                  f32x2 sa = (f32x2){0.f, 0.f}, sb = (f32x2){0.f, 0.f};
#pragma unroll
                  for (int r = 0; r < 16; r += 2) {
                    const f32x2 za = (f32x2){p0[r], p0[r + 1]}, zb = (f32x2){p1[r], p1[r + 1]};
                    f32x2 ea, eb; ea.x = __builtin_amdgcn_exp2f(-fabsf(za.x)); ea.y = __builtin_amdgcn_exp2f(-fabsf(za.y)); eb.x = __builtin_amdgcn_exp2f(-fabsf(zb.x)); eb.y = __builtin_amdgcn_exp2f(-fabsf(zb.y));
                    ea = ea + 1.0f; eb = eb + 1.0f;
                    f32x2 ga, gb; ga.x = __builtin_amdgcn_logf(ea.x); ga.y = __builtin_amdgcn_logf(ea.y); gb.x = __builtin_amdgcn_logf(eb.x); gb.y = __builtin_amdgcn_logf(eb.y);
                    f32x2 ma, mb; ma.x = 0.5f * (za.x - fabsf(za.x)); ma.y = 0.5f * (za.y - fabsf(za.y)); mb.x = 0.5f * (zb.x - fabsf(zb.x)); mb.y = 0.5f * (zb.y - fabsf(zb.y));
                    const f32x2 lba = ma - ga, lbb = mb - gb, la = lba - za, lb_ = lbb - zb;
                    p0[r] = lba.x; p0[r + 1] = lba.y; p1[r] = lbb.x; p1[r + 1] = lbb.y; l0v[r] = la.x; l0v[r + 1] = la.y; l1v[r] = lb_.x; l1v[r + 1] = lb_.y; }
                  if (band) {
#pragma unroll
                      for (int r = 0; r < 16; ++r) { if (!(crow(r, hi) < qrel)) { p0[r] = -INFINITY; l0v[r] = 0.f; } if (!(crow(r, hi) + 32 < qrel)) { p1[r] = -INFINITY; l1v[r] = 0.f; } } }
#pragma unroll
                  for (int r = 0; r < 16; r += 2) { sa += (f32x2){l0v[r], l0v[r + 1]}; sb += (f32x2){l1v[r], l1v[r + 1]}; }
                  rs0 = sa.x + sa.y; rs1 = sb.x + sb.y; }
                rs0 = swap_add(rs0); rs1 = swap_add(rs1);
                u32x4 h0, h1, h2, h3;
#define ATT_SPLIT(H, L, B) do { _Pragma("unroll") for (int k_ = 0; k_ < 4; ++k_) H[k_] = pk2(L[(B) + 2 * k_], L[(B) + 2 * k_ + 1]); } while (0)
                ATT_SPLIT(h0, l0v, 0); ATT_SPLIT(h1, l0v, 8); ATT_SPLIT(h2, l1v, 0); ATT_SPLIT(h3, l1v, 8);
#undef ATT_SPLIT
                f32x16 s0, s1;
                { const float c0 = R + rs1, c1 = R;
#pragma unroll
                  for (int r = 0; r < 16; ++r) { s0[r] = c0; s1[r] = c1; } }
#define ATT_BF(x) __builtin_bit_cast(bf16x8, x)
                s0 = __builtin_amdgcn_mfma_f32_32x32x16_bf16(Mp0, ATT_BF(h0), s0, 0, 0, 0); s1 = __builtin_amdgcn_mfma_f32_32x32x16_bf16(Mp0, ATT_BF(h2), s1, 0, 0, 0);
                s0 = __builtin_amdgcn_mfma_f32_32x32x16_bf16(Mp1, ATT_BF(h1), s0, 0, 0, 0); s1 = __builtin_amdgcn_mfma_f32_32x32x16_bf16(Mp1, ATT_BF(h3), s1, 0, 0, 0);
#pragma unroll
                for (int r = 0; r < 16; r += 2) { const f32x2 ta = (f32x2){p0[r], p0[r + 1]} + (f32x2){s0[r], s0[r + 1]}, tb = (f32x2){p1[r], p1[r + 1]} + (f32x2){s1[r], s1[r + 1]};
                    p0[r] = __builtin_amdgcn_exp2f(ta.x); p0[r + 1] = __builtin_amdgcn_exp2f(ta.y); p1[r] = __builtin_amdgcn_exp2f(tb.x); p1[r + 1] = __builtin_amdgcn_exp2f(tb.y); }
                R += rs0 + rs1;
                if (EARLY) { if (__all(R < -32.0f)) { wdone = true; if (lane == 0) __hip_atomic_fetch_add((LAS unsigned*)&flags[0], 1u, __ATOMIC_RELAXED, __HIP_MEMORY_SCOPE_WORKGROUP); } }
            }
            pw0 = (u32x4){pk2(p0[0], p0[1]), pk2(p0[2], p0[3]), pk2(p0[4], p0[5]), pk2(p0[6], p0[7])};
            pw1 = (u32x4){pk2(p0[8], p0[9]), pk2(p0[10], p0[11]), pk2(p0[12], p0[13]), pk2(p0[14], p0[15])};
            pw2 = (u32x4){pk2(p1[0], p1[1]), pk2(p1[2], p1[3]), pk2(p1[4], p1[5]), pk2(p1[6], p1[7])};
            pw3 = (u32x4){pk2(p1[8], p1[9]), pk2(p1[10], p1[11]), pk2(p1[12], p1[13]), pk2(p1[14], p1[15])};
            if (NDB == 4) {
                __builtin_amdgcn_sched_barrier(0);
#pragma unroll
                for (int i = 8; i < NDB * 4; ++i) { vlo[i] = vtr(vp + (i >> 2) * 4096 + (i & 3) * 1024); vhh[i] = vtr(vp + (i >> 2) * 4096 + (i & 3) * 1024 + 512); }
                __builtin_amdgcn_sched_barrier(0);
            }
#define ATT_PK(d_, k_) (bf16x8){vlo[(d_) * 4 + (k_)][0], vlo[(d_) * 4 + (k_)][1], vlo[(d_) * 4 + (k_)][2], vlo[(d_) * 4 + (k_)][3], vhh[(d_) * 4 + (k_)][0], vhh[(d_) * 4 + (k_)][1], vhh[(d_) * 4 + (k_)][2], vhh[(d_) * 4 + (k_)][3]}
#pragma unroll
            for (int dp = 0; dp < NDB; dp += 2) {
                o[dp] = __builtin_amdgcn_mfma_f32_32x32x16_bf16(ATT_BF(pw0), ATT_PK(dp, 0), o[dp], 0, 0, 0); o[dp + 1] = __builtin_amdgcn_mfma_f32_32x32x16_bf16(ATT_BF(pw0), ATT_PK(dp + 1, 0), o[dp + 1], 0, 0, 0);
                o[dp] = __builtin_amdgcn_mfma_f32_32x32x16_bf16(ATT_BF(pw1), ATT_PK(dp, 1), o[dp], 0, 0, 0); o[dp + 1] = __builtin_amdgcn_mfma_f32_32x32x16_bf16(ATT_BF(pw1), ATT_PK(dp + 1, 1), o[dp + 1], 0, 0, 0);
                o[dp] = __builtin_amdgcn_mfma_f32_32x32x16_bf16(ATT_BF(pw2), ATT_PK(dp, 2), o[dp], 0, 0, 0); o[dp + 1] = __builtin_amdgcn_mfma_f32_32x32x16_bf16(ATT_BF(pw2), ATT_PK(dp + 1, 2), o[dp + 1], 0, 0, 0);
                o[dp] = __builtin_amdgcn_mfma_f32_32x32x16_bf16(ATT_BF(pw3), ATT_PK(dp, 3), o[dp], 0, 0, 0); o[dp + 1] = __builtin_amdgcn_mfma_f32_32x32x16_bf16(ATT_BF(pw3), ATT_PK(dp + 1, 3), o[dp + 1], 0, 0, 0);
            }
#undef ATT_PK
        }
        ATT_WAIT_BAR();
        if (EARLY && wdone) { if (flags[0] == 8u) break; }
    }
#undef ATT_ISSUE
    float rli[16];
    if (MODE == 0) {
        lsum = swap_add(lsum);
        if (hi == 0) wsf[32 + r32] = lsum;
        LDS_WAIT();
#pragma unroll
        for (int r = 0; r < 16; ++r) rli[r] = __builtin_amdgcn_rcpf(wsf[32 + crow(r, hi)]);
    } else {
#pragma unroll
        for (int r = 0; r < 16; ++r) rli[r] = 1.0f;
    }
    bf16* Ow = Tn.O + (rowbase + q0 + wid * 32) * PITCH + ocol;
    { LAS bf16* stg = (LAS bf16*)(shm + L_OST) + wid * 4096;
      if (MODE == 0 && rpass == 1) {
          float gs[NDB];
#pragma unroll
          for (int d0 = 0; d0 < NDB; ++d0) gs[d0] = gsub[d0 * 32 + r32];
          float ssq[16];
#pragma unroll
          for (int r = 0; r < 16; ++r) { const int orow = crow(r, hi); float s = 0.f;
#pragma unroll
              for (int d0 = 0; d0 < NDB; ++d0) { const float o0 = __uint_as_float(((unsigned)stg[orow * DV + d0 * 32 + r32]) << 16); const float d = o0 - lam * (o[d0][r] * rli[r]); o[d0][r] = d; s += d * d; }
              ssq[r] = s; }
#pragma unroll
          for (int r = 0; r < 16; ++r) { const float s = half_sum32(ssq[r]);
              rli[r] = 1.0f / sqrtf(s * (1.0f / 128.0f) + 1e-6f); }
#pragma unroll
          for (int r = 0; r < 16; ++r)
#pragma unroll
              for (int d0 = 0; d0 < NDB; ++d0) o[d0][r] *= gs[d0];
          LDS_WAIT();
      }
#pragma unroll
      for (int r = 0; r < 16; ++r) { const int orow = crow(r, hi);
#pragma unroll
          for (int d0 = 0; d0 < NDB; ++d0) stg[orow * DV + d0 * 32 + r32] = (bf16)(pk2(o[d0][r] * rli[r], 0.f) & 0xffffu); }
      LDS_WAIT();
      if (!(MODE == 0 && rpass == 0)) {
      constexpr int CPR = DV / 8, RPI = 64 / CPR;
#pragma unroll
      for (int i = 0; i < 32 / RPI; ++i) { const int row = i * RPI + lane / CPR, ch = lane % CPR; const u32x4 v = *(const LAS u32x4*)(stg + row * DV + ch * 8); *(u32x4*)(Ow + (long)row * PITCH + ch * 8) = v; }
      LDS_WAIT(); } }
#undef ATT_BF
}
__device__ __forceinline__ bool unit_of(int vcu, int G, int i, int n_inst, int& inst, int& qb) {
    if (G == 256 && n_inst == 64) { if (i >= 8) return false; inst = vcu >> 2; const int pr = (vcu & 3) + 4 * (i >> 1); qb = (i & 1) ? 31 - pr : pr; return true; }
    const long L = (long)i * G + vcu; if (L >= (long)n_inst * 32) return false; inst = (int)(L >> 5); qb = (int)(L & 31); return true;
}
__device__ __forceinline__ bool unit_of_A(int vcu, int G, int i, int& b, int& head, int& r, int& qb) {
    if (G == 256) { if (i >= 8) return false; const int br = vcu >> 5, q = vcu & 31, q2 = (q + 16) & 31, brh = (br + i) & 7; head = i; b = brh >> 1; r = brh & 1;
        qb = ((i & 3) == 0) ? q : ((i & 3) == 1) ? 31 - q : ((i & 3) == 2) ? q2 : 31 - q2; return true; }
    int inst; if (!unit_of(vcu, G, i, 64, inst, qb)) return false; b = inst >> 4; head = (inst >> 1) & 7; r = inst & 1; return true;
}
__device__ __forceinline__ void unit_of_Aq(int qx, int idx, int& b, int& head, int& qb) { const int i = idx >> 5; qb = 31 - (idx & 31); b = qx >> 1;
    head = (qx & 1) ? ((i == 0) ? 6 : (i == 1) ? 4 : (i == 2) ? 3 : 2) : ((i == 0) ? 7 : (i == 1) ? 5 : (i == 2) ? 1 : 0); }
}


struct Frame {
    LAS unsigned char* lds;
    volatile LAS unsigned* MISC;
    gu32* ctl;
    int tid, lane, wave, vcu, G;
    unsigned char* ws;
};
__device__ __forceinline__ const float* inptr(const Frame& F, int i) { const unsigned lo = __builtin_amdgcn_readfirstlane(F.MISC[176 + 2 * i]), hi = __builtin_amdgcn_readfirstlane(F.MISC[177 + 2 * i]); return (const float*)(const GAS float*)(((unsigned long long)hi << 32) | lo); }
#define FIN(i) inptr(F, (i))
#define FOUT ((float*)inptr(F, 23))
enum { I_X = 0, I_C, I_ADAW, I_ADAB, I_NMIX, I_NMOE, I_AWQKV, I_AWO, I_ALAM, I_ASUBLN, I_KVNORM, I_KVADAW, I_KVADAB, I_KVW, I_BWQ, I_BWO, I_RW, I_RB, I_WGU, I_BGU, I_WD, I_BD, I_FNORM };
#define WSP(T_, off) ((T_*)(GAS T_*)(F.ws + (off)))

__device__ __forceinline__ void transpose_item(const float* W, int ldw, int k0, int n0, bf16* WT, int K, int drow0, LAS float* scr, int lane) {
    { const GAS float* wg = (const GAS float*)W + (size_t)k0 * ldw + n0 + (lane & 31) + (size_t)(lane >> 5) * ldw; float v[32];
#pragma unroll
      for (int i = 0; i < 32; ++i) v[i] = wg[(size_t)(2 * i) * ldw];
#pragma unroll
      for (int i = 0; i < 32; ++i) scr[(2 * i + (lane >> 5)) * 33 + (lane & 31)] = v[i]; }
    LDS_WAIT(); asm volatile("" ::: "memory");
    const int c = lane & 7;
#pragma unroll
    for (int j = 0; j < 4; ++j) { const int n = (lane >> 3) + 8 * j; const LAS float* s = scr + (8 * c) * 33 + n;
        v4u o; o.x = pk2(s[0 * 33], s[1 * 33]); o.y = pk2(s[2 * 33], s[3 * 33]); o.z = pk2(s[4 * 33], s[5 * 33]); o.w = pk2(s[6 * 33], s[7 * 33]);
        *(GAS v4u*)(WT + (size_t)(drow0 + n) * K + k0 + 8 * c) = o; }
    LDS_WAIT(); asm volatile("" ::: "memory");
}
__device__ __forceinline__ void transpose_item8(const float* W, int ldw, int k0, int n0, unsigned char* WT, int K, int drow0, LAS float* scr, int lane) {
    LAS unsigned* t = (LAS unsigned*)scr;
    const int kr = lane >> 4, nq = lane & 15;
    const GAS float* wp = (const GAS float*)W + (size_t)(k0 + 4 * kr) * ldw + n0 + 4 * nq;
    f32x4 v[8][4];
#pragma unroll
    for (int i = 0; i < 8; ++i)
#pragma unroll
        for (int j = 0; j < 4; ++j) v[i][j] = __builtin_nontemporal_load((const GAS f32x4*)(wp + (size_t)(16 * i + j) * ldw));
#pragma unroll
    for (int i = 0; i < 8; ++i)
#pragma unroll
        for (int c = 0; c < 4; ++c) t[(4 * nq + c) * 33 + 4 * i + kr] = pk4f8(v[i][0][c] * 256.0f, v[i][1][c] * 256.0f, v[i][2][c] * 256.0f, v[i][3][c] * 256.0f);
    LDS_WAIT(); asm volatile("" ::: "memory");
    const int c8 = lane & 7;
#pragma unroll
    for (int j = 0; j < 8; ++j) { const int n = (lane >> 3) + 8 * j; const LAS unsigned* s = t + n * 33 + 4 * c8;
        v4u o; o.x = s[0]; o.y = s[1]; o.z = s[2]; o.w = s[3];
        __builtin_nontemporal_store(o, (GAS v4u*)(WT + (size_t)(drow0 + n) * K + k0 + 16 * c8)); }
    LDS_WAIT(); asm volatile("" ::: "memory");
}
__device__ __forceinline__ void mod_item(const float* c, const float* W, int ldw, int n0, int s, float* out, int ldo, LAS float* scr, int lane) {
#pragma unroll
    for (int i = 0; i < 8; ++i) { const int idx = i * 64 + lane, b = idx >> 7, kk = idx & 127; const float v = c[b * 1024 + s * 128 + kk]; scr[idx] = v * __builtin_amdgcn_rcpf(1.0f + __builtin_amdgcn_exp2f(-v * LOG2E)); }
    LDS_WAIT(); asm volatile("" ::: "memory");
    float a0 = 0.f, a1 = 0.f, a2 = 0.f, a3 = 0.f;
    const GAS float* wp = (const GAS float*)W + (size_t)(s * 128) * ldw + n0 + lane;
    { float w[128];
#pragma unroll
      for (int k = 0; k < 128; ++k) w[k] = wp[(size_t)k * ldw];
#pragma unroll
      for (int k = 0; k < 128; k += 4) { const f32x4 c0 = *(const LAS f32x4*)(scr + k), c1 = *(const LAS f32x4*)(scr + 128 + k), c2 = *(const LAS f32x4*)(scr + 256 + k), c3 = *(const LAS f32x4*)(scr + 384 + k);
          a0 += (c0.x * w[k] + c0.y * w[k + 1]) + (c0.z * w[k + 2] + c0.w * w[k + 3]); a1 += (c1.x * w[k] + c1.y * w[k + 1]) + (c1.z * w[k + 2] + c1.w * w[k + 3]);
          a2 += (c2.x * w[k] + c2.y * w[k + 1]) + (c2.z * w[k + 2] + c2.w * w[k + 3]); a3 += (c3.x * w[k] + c3.y * w[k + 1]) + (c3.z * w[k + 2] + c3.w * w[k + 3]); } }
    out[0 * ldo + n0 + lane] = a0; out[1 * ldo + n0 + lane] = a1; out[2 * ldo + n0 + lane] = a2; out[3 * ldo + n0 + lane] = a3;
    LDS_WAIT(); asm volatile("" ::: "memory");
}
__device__ __forceinline__ void mod_reduce_pass(Frame& F) {
    const float* mp = WSP(const float, WS_MODP); float* mod = WSP(float, WS_MOD);
    for (int i = (int)blockIdx.x * (NWAVES * 64) + F.tid; i < MODN; i += F.G * NWAVES * 64) {
        float s = (i < DEPTH * BATCH * 6 * D) ? FIN(I_ADAB)[(size_t)(i / (BATCH * 6 * D)) * 6 * D + i % (6 * D)] : FIN(I_KVADAB)[(i - DEPTH * BATCH * 6 * D) % (2 * D)];
#pragma unroll
        for (int p = 0; p < MODS; ++p) s += mp[(size_t)p * MODN + i];
        mod[i] = s; }
}
__device__ __forceinline__ void expert_item(Frame& F, int lay, int r, LAS float* scr) {
    if (r < NE * 256) { const int le = lay * NE + r / 256, q = r % 256, kb = q / 32, nb = q % 32;
        const int n0 = nb * 64, isu = n0 >> 10, jb = n0 & 1023, drow = (jb >> 7) * 256 + isu * 128 + (jb & 127);
        transpose_item8(FIN(I_WGU) + (size_t)le * D * 2 * D, 2 * D, kb * 128, n0, WSP(unsigned char, WS_WGU) + (size_t)le * 2 * D * D, D, drow, scr, F.lane); }
    else { r -= NE * 256; const int le = lay * NE + r / 128, q = r % 128, kb = q / 16, nb = q % 16;
        transpose_item8(FIN(I_WD) + (size_t)le * D * D, D, kb * 128, nb * 64, WSP(unsigned char, WS_WD) + (size_t)le * D * D, D, nb * 64, scr, F.lane); }
}
__device__ __forceinline__ void expert_conv_unit(Frame& F, int lp, int cu) {
    LAS float* scr = (LAS float*)(F.lds + RING_OFF + F.wave * 16384);
#pragma unroll 1
    for (int t = 0; t < 4; ++t) { const int j = cu * 32 + F.wave + 8 * t; expert_item(F, 2 * lp + j / (NE * 384), j % (NE * 384), scr); }
}
__device__ __forceinline__ void p0_prologue(Frame& F) {
    LAS float* scr = (LAS float*)(F.lds + RING_OFF + F.wave * 16384);
    constexpr int I_MOD = (DEPTH * 96 + 32) * MODS;
    constexpr int IT_QKV = 2 * 16 * 96, IT_SQ = 2 * 16 * 32, IT_KV = 16 * 64;
    constexpr int NITEMS = I_MOD + IT_QKV + IT_SQ   + IT_KV + IT_SQ   + IT_SQ  ;
    const int gw = F.vcu * NWAVES + F.wave, NGW = F.G * NWAVES;
    for (int it = gw; it < NITEMS; it += NGW) {
        int r = it;
        if (r < I_MOD) { const int s = r % MODS, cch = r / MODS; float* pl = WSP(float, WS_MODP) + (size_t)s * MODN;
            if (cch < DEPTH * 96) { const int l = cch / 96, nb = cch % 96; mod_item(FIN(I_C), FIN(I_ADAW) + (size_t)l * D * 6 * D, 6 * D, nb * 64, s, pl + (size_t)l * BATCH * 6 * D, 6 * D, scr, F.lane); }
            else { const int nb = cch - DEPTH * 96; mod_item(FIN(I_C), FIN(I_KVADAW), 2 * D, nb * 64, s, pl + (size_t)DEPTH * BATCH * 6 * D, 2 * D, scr, F.lane); }
            continue; }
        r -= I_MOD;
        if (r < IT_QKV) { const int l = r / (16 * 96), q = r % (16 * 96), kb = q / 96, nb = q % 96;
            transpose_item(FIN(I_AWQKV) + (size_t)l * D * 3 * D, 3 * D, kb * 64, nb * 32, WSP(bf16, WS_WQKV) + (size_t)l * 3 * D * D, D, nb * 32, scr, F.lane); continue; }
        r -= IT_QKV;
        if (r < IT_SQ) { const int l = r / 512, q = r % 512, kb = q / 32, nb = q % 32;
            transpose_item(FIN(I_AWO) + (size_t)l * D * D, D, kb * 64, nb * 32, WSP(bf16, WS_WOA) + (size_t)l * D * D, D, nb * 32, scr, F.lane); continue; }
        r -= IT_SQ;
        if (r < IT_KV) { const int kb = r / 64, nb = r % 64;
            transpose_item(FIN(I_KVW), 2 * D, kb * 64, nb * 32, WSP(bf16, WS_WKV), D, nb * 32, scr, F.lane); continue; }
        r -= IT_KV;
        if (r < IT_SQ) { const int l = r / 512, q = r % 512, kb = q / 32, nb = q % 32;
            transpose_item(FIN(I_BWQ) + (size_t)l * D * D, D, kb * 64, nb * 32, WSP(bf16, WS_WQB) + (size_t)l * D * D, D, nb * 32, scr, F.lane); continue; }
        r -= IT_SQ;
        { const int l = r / 512, q = r % 512, kb = q / 32, nb = q % 32;
            transpose_item(FIN(I_BWO) + (size_t)l * D * D, D, kb * 64, nb * 32, WSP(bf16, WS_WOB) + (size_t)l * D * D, D, nb * 32, scr, F.lane); }
    }
}

__device__ __forceinline__ void norm_combine_pass(Frame& F, int l, bool dry = false) {
    int gw = F.vcu * NWAVES + F.wave; asm volatile("" : "+s"(gw));
    const int NGW = F.G * NWAVES;
    const int RPW = (T + NGW - 1) / NGW;
    const float* xin32 = FIN(I_X);
    bf16* xcur = WSP(bf16, WS_XCUR);
    const unsigned char* YS = WSP(const unsigned char, WS_YS); const int* slot_row = WSP(const int, WS_SLOT_ROW);
    const float* mod = WSP(const float, WS_MOD); const float* kvmod = WSP(const float, WS_KVMOD);
    const int m0 = gw * RPW; if (m0 >= T) return;
    const int mend = (m0 + RPW < T) ? m0 + RPW : T;
    const int b = m0 >> 13;
    f32x4 g2v[4], gnv[4], shv[4], scv[4];
#pragma unroll
    for (int j = 0; j < 4; ++j) { const int c0 = 4 * F.lane + 256 * j;
        g2v[j] = (l > 0) ? *(const GAS f32x4*)(mod + ((size_t)(l - 1) * BATCH + b) * 6 * D + 5 * D + c0) * (1.0f / 16.0f) : (f32x4){0.f, 0.f, 0.f, 0.f};
        if (l == DEPTH) { gnv[j] = *(const GAS f32x4*)(FIN(I_FNORM) + c0); shv[j] = (f32x4){0.f, 0.f, 0.f, 0.f}; scv[j] = (f32x4){0.f, 0.f, 0.f, 0.f}; }
        else { const float* md = mod + ((size_t)l * BATCH + b) * 6 * D; gnv[j] = *(const GAS f32x4*)(FIN(I_NMIX) + (size_t)l * D + c0); shv[j] = *(const GAS f32x4*)(md + c0); scv[j] = *(const GAS f32x4*)(md + D + c0) + 1.0f; } }
    int srl = 0;
    if (l > 0 && F.lane < (mend - m0) * 4) srl = slot_row[(size_t)m0 * 4 + F.lane];
    for (int mb = m0; mb < mend; mb += 2) {
        f32x4 v[2][4]; unsigned ys[2][4][4];
#pragma unroll
        for (int q = 0; q < 2; ++q) { const int m = (mb + q < mend) ? mb + q : mb;
#pragma unroll
            for (int j = 0; j < 4; ++j) {
                if (l == 0) v[q][j] = __builtin_nontemporal_load((const GAS f32x4*)(xin32 + (size_t)m * D + 4 * F.lane + 256 * j));
                else { const v2u r = __builtin_nontemporal_load((const GAS v2u*)(xcur + (size_t)m * D + 4 * F.lane + 256 * j)); v[q][j] = (f32x4){bflo(r.x), bfhi(r.x), bflo(r.y), bfhi(r.y)}; } }
            if (l > 0) {
#pragma unroll
                for (int s = 0; s < 4; ++s) { const int rw = (RPW <= 16) ? __builtin_amdgcn_readlane(srl, ((m - m0) * 4 + s) & 63) : __builtin_amdgcn_readfirstlane(slot_row[(size_t)m * 4 + s]);
#pragma unroll
                    for (int j = 0; j < 4; ++j) ys[q][s][j] = __builtin_nontemporal_load((const GAS unsigned*)(YS + (size_t)rw * D + 4 * F.lane + 256 * j)); } } }
#pragma unroll
        for (int q = 0; q < 2; ++q) { const int m = mb + q; if (m >= mend) break;
            if (l > 0) {
#pragma unroll
                for (int j = 0; j < 4; ++j) { f32x4 acc = (f32x4){0.f, 0.f, 0.f, 0.f};
#pragma unroll
                    for (int s = 0; s < 4; ++s) acc += f8x4_to_f32(ys[q][s][j]);
                    v[q][j] += g2v[j] * acc; }
                if (l < DEPTH && !dry) {
#pragma unroll
                    for (int j = 0; j < 4; ++j) { v2u w; w.x = pk2(v[q][j].x, v[q][j].y); w.y = pk2(v[q][j].z, v[q][j].w); __builtin_nontemporal_store(w, (GAS v2u*)(xcur + (size_t)m * D + 4 * F.lane + 256 * j)); }
                }
            }
            float ss = 0.f;
#pragma unroll
            for (int j = 0; j < 4; ++j) ss += (v[q][j].x * v[q][j].x + v[q][j].y * v[q][j].y) + (v[q][j].z * v[q][j].z + v[q][j].w * v[q][j].w);
            const float rstd = 1.0f / sqrtf(wave_sum(ss) * (1.0f / D) + EPS);
            if (l == DEPTH) {
#pragma unroll
                for (int j = 0; j < 4; ++j) __builtin_nontemporal_store(v[q][j] * rstd * gnv[j], (GAS f32x4*)(FOUT + (size_t)m * D + 4 * F.lane + 256 * j));
            } else {
#pragma unroll
                for (int j = 0; j < 4; ++j) { const int c0 = 4 * F.lane + 256 * j; const f32x4 h = (v[q][j] * rstd * gnv[j]) * scv[j] + shv[j];
                    v2u w; w.x = pk2(h.x, h.y); w.y = pk2(h.z, h.w); *(GAS v2u*)(WSP(bf16, WS_H) + (size_t)m * D + c0) = w; }
                if (l == 2) {
                    const float* kd = kvmod + (size_t)b * 2 * D;
#pragma unroll
                    for (int j = 0; j < 4; ++j) { const int c0 = 4 * F.lane + 256 * j;
                        const f32x4 gn = *(const GAS f32x4*)(FIN(I_KVNORM) + c0), sh = *(const GAS f32x4*)(kd + c0), sc = *(const GAS f32x4*)(kd + D + c0);
                        const f32x4 h = (v[q][j] * rstd * gn) * (sc + 1.0f) + sh;
                        v2u w; w.x = pk2(h.x, h.y); w.y = pk2(h.z, h.w); *(GAS v2u*)(WSP(bf16, WS_HKV) + (size_t)m * D + c0) = w; }
                }
            }
        }
    }
}

__device__ __forceinline__ void norm_combine_pass8(Frame& F, int l, bool dry = false) {
    int gw = F.vcu * NWAVES + F.wave; asm volatile("" : "+s"(gw));
    const int NGW = F.G * NWAVES;
    const int RPW = (T + NGW - 1) / NGW;
    bf16* xcur = WSP(bf16, WS_XCUR);
    const unsigned char* YS = WSP(const unsigned char, WS_YS); const int* slot_row = WSP(const int, WS_SLOT_ROW);
    const float* mod = WSP(const float, WS_MOD); const float* kvmod = WSP(const float, WS_KVMOD);
    const int m0 = gw * RPW; if (m0 >= T) return;
    const int mend = (m0 + RPW < T) ? m0 + RPW : T;
    const int b = m0 >> 13;
    const int cl = 8 * F.lane;
    f32x4 g2v[4], gnv[4], shv[4], scv[4];
#pragma unroll
    for (int jh = 0; jh < 4; ++jh) { const int c0 = cl + 512 * (jh >> 1) + 4 * (jh & 1);
        g2v[jh] = *(const GAS f32x4*)(mod + ((size_t)(l - 1) * BATCH + b) * 6 * D + 5 * D + c0) * (1.0f / 16.0f);
        if (l == DEPTH) { gnv[jh] = *(const GAS f32x4*)(FIN(I_FNORM) + c0); shv[jh] = (f32x4){0.f, 0.f, 0.f, 0.f}; scv[jh] = (f32x4){0.f, 0.f, 0.f, 0.f}; }
        else { const float* md = mod + ((size_t)l * BATCH + b) * 6 * D; gnv[jh] = *(const GAS f32x4*)(FIN(I_NMIX) + (size_t)l * D + c0); shv[jh] = *(const GAS f32x4*)(md + c0); scv[jh] = *(const GAS f32x4*)(md + D + c0) + 1.0f; } }
    int srl = 0;
    if (F.lane < (mend - m0) * 4) srl = slot_row[(size_t)m0 * 4 + F.lane];
    for (int mb = m0; mb < mend; mb += 4) {
        v4u xr[4][2]; v2u ys[4][4][2];
#pragma unroll
        for (int q = 0; q < 4; ++q) { const int m = (mb + q < mend) ? mb + q : mb;
#pragma unroll
            for (int j = 0; j < 2; ++j) xr[q][j] = __builtin_nontemporal_load((const GAS v4u*)(xcur + (size_t)m * D + cl + 512 * j));
#pragma unroll
            for (int s = 0; s < 4; ++s) { const int rw = (RPW <= 16) ? __builtin_amdgcn_readlane(srl, ((m - m0) * 4 + s) & 63) : __builtin_amdgcn_readfirstlane(slot_row[(size_t)m * 4 + s]);
#pragma unroll
                for (int j = 0; j < 2; ++j) ys[q][s][j] = __builtin_nontemporal_load((const GAS v2u*)(YS + (size_t)rw * D + cl + 512 * j)); } }
#pragma unroll
        for (int q = 0; q < 4; ++q) { const int m = mb + q; if (m >= mend) break;
            f32x4 v[4];
#pragma unroll
            for (int jh = 0; jh < 4; ++jh) { const int j = jh >> 1, h = jh & 1; const unsigned w0 = xr[q][j][2 * h], w1 = xr[q][j][2 * h + 1];
                f32x4 acc = f8x4_to_f32(ys[q][0][j][h]);
#pragma unroll
                for (int s = 1; s < 4; ++s) acc += f8x4_to_f32(ys[q][s][j][h]);
                v[jh] = (f32x4){bflo(w0), bfhi(w0), bflo(w1), bfhi(w1)} + g2v[jh] * acc; }
            if (l < DEPTH && !dry) {
#pragma unroll
                for (int j = 0; j < 2; ++j) { v4u w; w.x = pk2(v[2 * j].x, v[2 * j].y); w.y = pk2(v[2 * j].z, v[2 * j].w); w.z = pk2(v[2 * j + 1].x, v[2 * j + 1].y); w.w = pk2(v[2 * j + 1].z, v[2 * j + 1].w);
                    __builtin_nontemporal_store(w, (GAS v4u*)(xcur + (size_t)m * D + cl + 512 * j)); }
            }
            float ss = 0.f;
#pragma unroll
            for (int jh = 0; jh < 4; ++jh) ss += (v[jh].x * v[jh].x + v[jh].y * v[jh].y) + (v[jh].z * v[jh].z + v[jh].w * v[jh].w);
            const float rstd = 1.0f / sqrtf(wave_sum(ss) * (1.0f / D) + EPS);
            if (l == DEPTH) {
#pragma unroll
                for (int jh = 0; jh < 4; ++jh) __builtin_nontemporal_store(v[jh] * rstd * gnv[jh], (GAS f32x4*)(FOUT + (size_t)m * D + cl + 512 * (jh >> 1) + 4 * (jh & 1)));
            } else {
#pragma unroll
                for (int j = 0; j < 2; ++j) { const f32x4 h0 = (v[2 * j] * rstd * gnv[2 * j]) * scv[2 * j] + shv[2 * j], h1 = (v[2 * j + 1] * rstd * gnv[2 * j + 1]) * scv[2 * j + 1] + shv[2 * j + 1];
                    v4u w; w.x = pk2(h0.x, h0.y); w.y = pk2(h0.z, h0.w); w.z = pk2(h1.x, h1.y); w.w = pk2(h1.z, h1.w); *(GAS v4u*)(WSP(bf16, WS_H) + (size_t)m * D + cl + 512 * j) = w; }
                if (l == 2) {
                    const float* kd = kvmod + (size_t)b * 2 * D;
#pragma unroll
                    for (int j = 0; j < 2; ++j) { f32x4 hh[2];
#pragma unroll
                        for (int h = 0; h < 2; ++h) { const int c0 = cl + 512 * j + 4 * h;
                            const f32x4 gn = *(const GAS f32x4*)(FIN(I_KVNORM) + c0), sh = *(const GAS f32x4*)(kd + c0), sc = *(const GAS f32x4*)(kd + D + c0);
                            hh[h] = (v[2 * j + h] * rstd * gn) * (sc + 1.0f) + sh; }
                        v4u w; w.x = pk2(hh[0].x, hh[0].y); w.y = pk2(hh[0].z, hh[0].w); w.z = pk2(hh[1].x, hh[1].y); w.w = pk2(hh[1].z, hh[1].w); *(GAS v4u*)(WSP(bf16, WS_HKV) + (size_t)m * D + cl + 512 * j) = w; }
                }
            }
        }
    }
}

__device__ __forceinline__ void diff_combine_pass(Frame& F, int l) {
    const int gw = F.vcu * NWAVES + F.wave, NGW = F.G * NWAVES;
    const float lam_init = (l == 0) ? 0.2f : (0.8f - 0.6f * 0.74081822068171788f);
    const float* lv = FIN(I_ALAM) + (size_t)l * 256;
    const float s01 = wave_sum(lv[F.lane] * lv[64 + F.lane]), s23 = wave_sum(lv[128 + F.lane] * lv[192 + F.lane]);
    const float lam = expf(s01) - expf(s23) + lam_init;
    const float* sg = FIN(I_ASUBLN) + (size_t)l * 128 + (16 * F.lane) % 128;
    float gsub[16];
#pragma unroll
    for (int i = 0; i < 16; ++i) gsub[i] = sg[i] * (1.0f - lam_init);
    const bf16* O0 = WSP(const bf16, WS_O0); const bf16* O1 = WSP(const bf16, WS_O1); bf16* OC = WSP(bf16, WS_OC);
    for (int m = gw; m < T; m += NGW) {
        const size_t off = (size_t)m * D + 16 * F.lane;
        const v4u a0 = *(const GAS v4u*)(O0 + off), a1 = *(const GAS v4u*)(O0 + off + 8), b0 = *(const GAS v4u*)(O1 + off), b1 = *(const GAS v4u*)(O1 + off + 8);
        float d[16];
#pragma unroll
        for (int k = 0; k < 4; ++k) { d[2 * k] = bflo(a0[k]) - lam * bflo(b0[k]); d[2 * k + 1] = bfhi(a0[k]) - lam * bfhi(b0[k]); d[8 + 2 * k] = bflo(a1[k]) - lam * bflo(b1[k]); d[8 + 2 * k + 1] = bfhi(a1[k]) - lam * bfhi(b1[k]); }
        float ss = 0.f;
#pragma unroll
        for (int i = 0; i < 16; ++i) ss += d[i] * d[i];
        ss += __shfl_xor(ss, 1); ss += __shfl_xor(ss, 2); ss += __shfl_xor(ss, 4);
        const float rstd = 1.0f / sqrtf(ss * (1.0f / 128.0f) + EPS);
        v4u w0, w1;
#pragma unroll
        for (int k = 0; k < 4; ++k) { w0[k] = pk2(d[2 * k] * rstd * gsub[2 * k], d[2 * k + 1] * rstd * gsub[2 * k + 1]); w1[k] = pk2(d[8 + 2 * k] * rstd * gsub[8 + 2 * k], d[8 + 2 * k + 1] * rstd * gsub[8 + 2 * k + 1]); }
        *(GAS v4u*)(OC + off) = w0; *(GAS v4u*)(OC + off + 8) = w1;
    }
}

__device__ __forceinline__ void router_pass(Frame& F, int l, bool dry = false) {
    constexpr int HS_LD = 1028;
    LAS float* hs = (LAS float*)(F.lds + RING_OFF); LAS float* red = (LAS float*)(F.lds + RING_OFF + 69632);
    LAS int* tabE = (LAS int*)(F.lds + TAB_OFF); LAS int* tabP = tabE + 1024; LAS float* tabG = (LAS float*)(tabP + 1024);
    volatile LAS unsigned* lcnt = F.MISC + 80; volatile LAS unsigned* gbase = F.MISC + 120;
    const bf16* xcur = WSP(const bf16, WS_XCUR); const float* mod = WSP(const float, WS_MOD);
    const float* rwt = FIN(I_RW) + (size_t)l * D * NE; const float* rbs = FIN(I_RB) + (size_t)l * NE;
    const int NGRP = T / 16, gpb = (NGRP + F.G - 1) / F.G;
    const int g0 = (int)blockIdx.x * gpb; const int gn_ = (g0 + gpb <= NGRP) ? gpb : (NGRP > g0 ? NGRP - g0 : 0);
    if (F.tid < NE) lcnt[F.tid] = 0u;
    const int e = F.lane & 31, kh = F.lane >> 5, kb = 128 * F.wave;
    const int fn = F.lane & 15, fq = F.lane >> 4;
    v4u wh[4][2], wl[4][2];
#pragma unroll
    for (int s = 0; s < 4; ++s)
#pragma unroll
        for (int nh = 0; nh < 2; ++nh) { float w8[8];
#pragma unroll
            for (int i = 0; i < 8; ++i) w8[i] = rwt[(size_t)(kb + 32 * s + 8 * fq + i) * NE + 16 * nh + fn];
#pragma unroll
            for (int i = 0; i < 4; ++i) { const unsigned h = pk2(w8[2 * i], w8[2 * i + 1]); wh[s][nh][i] = h; wl[s][nh][i] = pk2(w8[2 * i] - bflo(h), w8[2 * i + 1] - bfhi(h)); } }
    const float rbe = rbs[e];
    const int b = (g0 * 16) >> 13;
    f32x4 gnv[4], shv[4], scv[4];
    { const float* md = mod + ((size_t)l * BATCH + b) * 6 * D;
#pragma unroll
      for (int j = 0; j < 4; ++j) { const int c0 = 4 * F.lane + 256 * j; gnv[j] = *(const GAS f32x4*)(FIN(I_NMOE) + (size_t)l * D + c0); shv[j] = *(const GAS f32x4*)(md + 3 * D + c0); scv[j] = *(const GAS f32x4*)(md + 4 * D + c0) + 1.0f; } }
    v2u xr[2][4];
    if (gn_ > 0) {
#pragma unroll
        for (int rr = 0; rr < 2; ++rr)
#pragma unroll
            for (int j = 0; j < 4; ++j) xr[rr][j] = __builtin_nontemporal_load((const GAS v2u*)(xcur + (size_t)(g0 * 16 + 2 * F.wave + rr) * D + 4 * F.lane + 256 * j));
    }
    __syncthreads();
    for (int gi = 0; gi < gn_; ++gi) {
        const int m0 = (g0 + gi) * 16;
#pragma unroll
        for (int rr = 0; rr < 2; ++rr) { const int r = 2 * F.wave + rr, m = m0 + r; float ss = 0.f; f32x4 xv[4];
#pragma unroll
            for (int j = 0; j < 4; ++j) { xv[j] = (f32x4){bflo(xr[rr][j].x), bfhi(xr[rr][j].x), bflo(xr[rr][j].y), bfhi(xr[rr][j].y)}; ss += (xv[j].x * xv[j].x + xv[j].y * xv[j].y) + (xv[j].z * xv[j].z + xv[j].w * xv[j].w); }
            const float rstd = 1.0f / sqrtf(wave_sum(ss) * (1.0f / D) + EPS);
#pragma unroll
            for (int j = 0; j < 4; ++j) { const int c0 = 4 * F.lane + 256 * j; const f32x4 h = (xv[j] * rstd * gnv[j]) * scv[j] + shv[j];
                *(LAS f32x4*)(hs + r * HS_LD + c0) = h;
                *(GAS unsigned*)(WSP(unsigned char, WS_H) + (size_t)m * D + c0) = pk4f8(h.x, h.y, h.z, h.w); } }
        if (gi + 1 < gn_) {
#pragma unroll
            for (int rr = 0; rr < 2; ++rr)
#pragma unroll
                for (int j = 0; j < 4; ++j) xr[rr][j] = __builtin_nontemporal_load((const GAS v2u*)(xcur + (size_t)(m0 + 16 + 2 * F.wave + rr) * D + 4 * F.lane + 256 * j));
        }
        __syncthreads();
        { f32x4 accL[2] = {(f32x4){0.f, 0.f, 0.f, 0.f}, (f32x4){0.f, 0.f, 0.f, 0.f}};
#pragma unroll
          for (int s = 0; s < 4; ++s) { const LAS float* hp = hs + fn * HS_LD + kb + 32 * s + 8 * fq; const f32x4 a0 = *(const LAS f32x4*)hp, a1 = *(const LAS f32x4*)(hp + 4);
              v4u ah, al;
              ah.x = pk2(a0.x, a0.y); ah.y = pk2(a0.z, a0.w); ah.z = pk2(a1.x, a1.y); ah.w = pk2(a1.z, a1.w);
              al.x = pk2(a0.x - bflo(ah.x), a0.y - bfhi(ah.x)); al.y = pk2(a0.z - bflo(ah.y), a0.w - bfhi(ah.y)); al.z = pk2(a1.x - bflo(ah.z), a1.y - bfhi(ah.z)); al.w = pk2(a1.z - bflo(ah.w), a1.w - bfhi(ah.w));
#pragma unroll
              for (int nh = 0; nh < 2; ++nh) {
                  accL[nh] = __builtin_amdgcn_mfma_f32_16x16x32_bf16(__builtin_bit_cast(bf16x8, ah), __builtin_bit_cast(bf16x8, wh[s][nh]), accL[nh], 0, 0, 0);
                  accL[nh] = __builtin_amdgcn_mfma_f32_16x16x32_bf16(__builtin_bit_cast(bf16x8, ah), __builtin_bit_cast(bf16x8, wl[s][nh]), accL[nh], 0, 0, 0);
                  accL[nh] = __builtin_amdgcn_mfma_f32_16x16x32_bf16(__builtin_bit_cast(bf16x8, al), __builtin_bit_cast(bf16x8, wh[s][nh]), accL[nh], 0, 0, 0); } }
#pragma unroll
          for (int nh = 0; nh < 2; ++nh)
#pragma unroll
              for (int i = 0; i < 4; ++i) red[(F.wave * 16 + 4 * fq + i) * 32 + 16 * nh + fn] = accL[nh][i]; }
        __syncthreads();
        { const int r = 2 * F.wave + kh, tl = gi * 16 + r; float s = rbe;
#pragma unroll
          for (int p = 0; p < 8; ++p) s += red[(p * 16 + r) * 32 + e];
          float tv[4]; int ti[4];
#pragma unroll
          for (int j = 0; j < 4; ++j) { float bvv = s; int bi = e;
#define RT_STEP(GETV, GETI) do { const float ov = GETV; const int oi = GETI; if (ov > bvv || (ov == bvv && oi < bi)) { bvv = ov; bi = oi; } } while (0)
#define RT_DPP(x_, c_) __builtin_amdgcn_update_dpp(0, (x_), (c_), 0xf, 0xf, false)
              RT_STEP(__int_as_float(RT_DPP(__float_as_int(bvv), 0xB1)), RT_DPP(bi, 0xB1));
              RT_STEP(__int_as_float(RT_DPP(__float_as_int(bvv), 0x4E)), RT_DPP(bi, 0x4E));
              RT_STEP(__int_as_float(RT_DPP(__float_as_int(bvv), 0x141)), RT_DPP(bi, 0x141));
              RT_STEP(__int_as_float(RT_DPP(__float_as_int(bvv), 0x140)), RT_DPP(bi, 0x140));
              RT_STEP(__int_as_float(__builtin_amdgcn_ds_swizzle(__float_as_int(bvv), 0x401F)), __builtin_amdgcn_ds_swizzle(bi, 0x401F));
#undef RT_STEP
#undef RT_DPP
              tv[j] = bvv; ti[j] = bi; if (e == bi) s = -INFINITY; }
          const float e1 = expf(tv[1] - tv[0]), e2 = expf(tv[2] - tv[0]), e3 = expf(tv[3] - tv[0]); const float inv = 1.0f / (1.0f + e1 + e2 + e3);
          if (e < 4 && !dry) { const int me = (e == 0) ? ti[0] : (e == 1) ? ti[1] : (e == 2) ? ti[2] : ti[3]; const float mg = ((e == 0) ? 1.0f : (e == 1) ? e1 : (e == 2) ? e2 : e3) * inv;
              const unsigned lp = __hip_atomic_fetch_add((LAS unsigned*)&lcnt[me], 1u, __ATOMIC_RELAXED, __HIP_MEMORY_SCOPE_WORKGROUP); tabE[tl * 4 + e] = me; tabP[tl * 4 + e] = (int)lp; tabG[tl * 4 + e] = mg; } }
    }
    __syncthreads();
    if (dry) return;
    if (F.tid < NE) gbase[F.tid] = __hip_atomic_fetch_add(F.ctl + CW_CNT + (l * NE + F.tid) * 64, lcnt[F.tid], RLX_AGENT);
    __syncthreads();
    { const int ntok = gn_ * 16; int* slot_e = WSP(int, WS_SLOT_E); int* slot_pos = WSP(int, WS_SLOT_POS); float* slot_gate = WSP(float, WS_SLOT_GATE);
      for (int i = F.tid; i < ntok * 4; i += NWAVES * 64) { const int tl = i >> 2; const int m = (g0 + (tl >> 4)) * 16 + (tl & 15);
          const int ee = tabE[i], pp = (int)gbase[ee] + tabP[i]; slot_e[(size_t)m * 4 + (i & 3)] = ee; slot_pos[(size_t)m * 4 + (i & 3)] = pp; slot_gate[(size_t)m * 4 + (i & 3)] = tabG[i];
          WSP(int, WS_XG)[(size_t)ee * TOK_CAP + pp] = m; } }
    __syncthreads();
}

__device__ __forceinline__ void moe_offsets(Frame& F, int l) {
    if (F.tid < 64) {
        const unsigned c = (F.tid < NE) ? __hip_atomic_load(F.ctl + CW_CNT + (l * NE + F.tid) * 64, RLX_AGENT) : 0u;
        const unsigned t = (c + 255u) >> 8; unsigned s = t;
#pragma unroll
        for (int o = 1; o < 32; o <<= 1) { const unsigned v = __shfl_up(s, o); if ((F.tid & 63) >= o) s += v; }
        if (F.tid < NE) { F.MISC[F.tid] = s - t; F.MISC[40 + F.tid] = (s - t) * 256u; }
        if (F.tid == NE - 1) F.MISC[32] = s; }
    __syncthreads();
}
__device__ __forceinline__ void slot_rows_pass(Frame& F, int l) {
    const int* slot_e = WSP(const int, WS_SLOT_E); const int* slot_pos = WSP(const int, WS_SLOT_POS); const float* slot_gate = WSP(const float, WS_SLOT_GATE);
    int* slot_row = WSP(int, WS_SLOT_ROW); float* rgate = WSP(float, WS_RGATE);
    for (int a = (int)blockIdx.x * (NWAVES * 64) + F.tid; a < T * TOPK; a += F.G * NWAVES * 64) {
        const int row = (int)F.MISC[40 + slot_e[a]] + slot_pos[a]; rgate[row] = slot_gate[a]; slot_row[a] = row; }
}
__device__ __forceinline__ void knorm_pass(Frame& F, int l) {
    volatile LAS unsigned* kred = F.MISC + 224;
    const bf16* K = WSP(const bf16, WS_K);
    for (int ch = (int)blockIdx.x; ch < T / 128; ch += F.G) {
        if (F.tid < 16) kred[F.tid] = 0u;
        __syncthreads();
        float mx = 0.f;
#pragma unroll 4
        for (int i = 0; i < 16; ++i) { const size_t off = (size_t)(ch * 128 + F.wave * 16 + i) * D + 16 * F.lane;
            const v4u a0 = *(const GAS v4u*)(K + off), a1 = *(const GAS v4u*)(K + off + 8); float s = 0.f;
#pragma unroll
            for (int k = 0; k < 4; ++k) { const float x0 = bflo(a0[k]), x1 = bfhi(a0[k]), x2 = bflo(a1[k]), x3 = bfhi(a1[k]); s += (x0 * x0 + x1 * x1) + (x2 * x2 + x3 * x3); }
            s += __shfl_xor(s, 1); s += __shfl_xor(s, 2); mx = fmaxf(mx, s); }
        if ((F.lane & 3) == 0) __hip_atomic_fetch_max((LAS unsigned*)&kred[F.lane >> 2], __float_as_uint(mx), __ATOMIC_RELAXED, __HIP_MEMORY_SCOPE_WORKGROUP);
        __syncthreads();
        if (F.tid < 16) __hip_atomic_fetch_max(F.ctl + CW_KMAX + ((l * BATCH + (ch * 128) / SEQ) * 16 + F.tid) * 16, kred[F.tid], RLX_AGENT);
        __syncthreads();
    }
}


#ifndef MK_REP
#define MK_REP 0
#endif
#ifndef MK_VAR
#define MK_VAR 0
#endif
#ifndef MK_DIS
#define MK_DIS 0
#endif
#ifndef MK_PER_STEP
#define MK_PER_STEP 0
#endif
#ifndef MK_XCID
#define MK_XCID 1
#endif
#ifndef MK_A_EARLY
#define MK_A_EARLY true
#endif
#ifndef MK_SB_EARLY
#define MK_SB_EARLY true
#endif
constexpr int SPL = 10, N_STEPS = 3 + SPL * DEPTH;
struct Args { const float* in[23]; float* out; unsigned char* ws; int st_lo, st_hi, pad0, pad1; };
static_assert(sizeof(Args) == 23 * 8 + 8 + 8 + 16, "Args has no padding bytes");

__global__ void __launch_bounds__(NWAVES * 64, 2) mk_fwd(Args args) {
    extern __shared__ __attribute__((aligned(16))) unsigned char lds[];
    Frame F;
    F.lds = (LAS unsigned char*)lds;
    F.MISC = (volatile LAS unsigned*)(F.lds + MISC_OFF);
    F.tid = threadIdx.x; F.lane = F.tid & 63; F.wave = __builtin_amdgcn_readfirstlane(F.tid >> 6);
    const int wave0 = F.wave;
    F.G = gridDim.x; { const int bx = blockIdx.x; F.vcu = (F.G % 8 == 0) ? (bx % 8) * (F.G / 8) + bx / 8 : bx; }
    F.ws = args.ws; F.ctl = (gu32*)(args.ws + WS_CTL);
    for (int u = F.tid; u < 176; u += NWAVES * 64) F.MISC[u] = 0u;
    if (F.tid == 0) F.MISC[241] = 0u;
    if (F.tid < 24) { const unsigned long long p = (F.tid < 23) ? (unsigned long long)args.in[F.tid] : (unsigned long long)args.out; F.MISC[176 + 2 * F.tid] = (unsigned)p; F.MISC[177 + 2 * F.tid] = (unsigned)(p >> 32); }
    __syncthreads();
    if (F.tid == 0) { const unsigned xc = xb_xcc_id() & 7u; F.MISC[242] = xc; F.MISC[243] = __hip_atomic_fetch_add(F.ctl + CW_XRANK + 64 * xc, 1u, RLX_AGENT); }
    __syncthreads();
    int cid = (int)blockIdx.x;
    const int lo = args.st_lo, hi = args.st_hi;
    XcdBarrier bar; bar.bar = (unsigned*)(args.ws + WS_CTL) + CW_BAR; bar.x = 0; bar.st = nullptr;
    if (hi - lo > 1) bar = xcd_barrier_post((unsigned*)(args.ws + WS_CTL) + CW_BAR, F.MISC + 160);
#define IN(k) (lo <= (k) && (k) < hi)
#define REFRESH() do { int t_; asm volatile("v_mbcnt_lo_u32_b32 %0, -1, 0\n\tv_mbcnt_hi_u32_b32 %0, -1, %0\n\tv_lshl_add_u32 %0, %1, 6, %0" : "=&v"(t_) : "s"(wave0)); F.tid = t_; F.lane = t_ & 63; F.wave = wave0; } while (0)
#define SEAM(k) do { if (IN(k) && IN((k) + 1)) { xcd_barrier(bar); if (MK_REP & 4096) xcd_barrier(bar); } } while (0)
#define SEAM_IF(k, c) do { if ((c) && IN(k) && IN((k) + 1)) { xcd_barrier(bar); if (MK_REP & 4096) xcd_barrier(bar); } } while (0)

    for (int rep = 0; rep < ((MK_REP & 1) ? 2 : 1); ++rep) if (IN(0) && !(MK_DIS & 1)) { REFRESH(); p0_prologue(F); }
    SEAM(0);
    if (MK_XCID && IN(0) && IN(1) && (F.G % 8) == 0) {
        bool even = true;
#pragma unroll
        for (int x = 0; x < 8; ++x) even = even && (__hip_atomic_load(F.ctl + CW_XRANK + 64 * x, RLX_AGENT) == (unsigned)(F.G / 8));
        if (even) { cid = __builtin_amdgcn_readfirstlane((int)(F.MISC[243] * 8u + F.MISC[242])); F.vcu = (cid % 8) * (F.G / 8) + cid / 8; }
    }
    if (IN(1)) { REFRESH(); mod_reduce_pass(F); }
    SEAM(1);
    for (int l = 0; l < DEPTH; ++l) {
        const int sb = 2 + SPL * l;
        const bool isA = (l < 2);
        if ((MK_REP & 2) && IN(sb + 0)) { REFRESH(); if (l == 0) norm_combine_pass(F, 0, true); else norm_combine_pass8(F, l, true); }
        if (IN(sb + 0) && !(MK_DIS & 2)) { REFRESH(); if (l == 0) norm_combine_pass(F, 0); else norm_combine_pass8(F, l); }
        SEAM(sb + 0);
        for (int rep = 0; rep < ((MK_REP & 4) ? 2 : 1); ++rep)
        if (IN(sb + 1) && !(MK_DIS & 4)) {
            if (isA) {
                pg8::Gemm g{WSP(const bf16, WS_H), WSP(const bf16, WS_WQKV) + (size_t)l * 3 * D * D, T, 3 * D, D}; pg8::StaticOrder S; S.init(T, 3 * D, F.G, cid);
                pg8::EpiBf16 E{WSP(bf16, WS_Q), D, D, (size_t)(WS_K - WS_Q) / 2, QSCALE, (unsigned*)(F.ws + WS_CTL) + CW_KMAX + (size_t)l * BATCH * 16 * 16, SEQ};
                pg8::gemm_phase<pg8::EpiBf16, pg8::StaticOrder, true, true>(F.lds + RING_OFF, g, S, E, wave0);
            } else {
                { pg8::Gemm g{WSP(const bf16, WS_H), WSP(const bf16, WS_WQB) + (size_t)(l - 2) * D * D, T, D, D}; pg8::StaticOrder S; S.init(T, D, F.G, cid);
                  pg8::EpiBf16 E{WSP(bf16, WS_Q), D, D, 0, QSCALE, nullptr, SEQ};
                  pg8::gemm_phase<pg8::EpiBf16, pg8::StaticOrder, true, true>(F.lds + RING_OFF, g, S, E, wave0); }
                if (l == 2) {
                    __syncthreads();
                    pg8::Gemm g{WSP(const bf16, WS_HKV), WSP(const bf16, WS_WKV), T, 2 * D, D}; pg8::StaticOrder S; S.init(T, 2 * D, F.G, cid);
                    pg8::EpiBf16 E{WSP(bf16, WS_KSH), D, D, (size_t)(WS_VSH - WS_KSH) / 2, 1.0f, nullptr, SEQ};
                    pg8::gemm_phase<pg8::EpiBf16, pg8::StaticOrder, true, true>(F.lds + RING_OFF, g, S, E, wave0); }
            }
        }
        SEAM(sb + 1);
        for (int rep = 0; rep < (((MK_REP & 8) && isA) || ((MK_REP & 16) && !isA) ? 2 : 1); ++rep)
        if (IN(sb + 3)) {
            REFRESH();
            if (isA && !(MK_DIS & 8)) {
                const float lam_init = (l == 0) ? 0.2f : (0.8f - 0.6f * 0.74081822068171788f);
                float lam; { const float* lv = FIN(I_ALAM) + (size_t)l * 256; const int ln = F.tid & 63;
                    const float s01 = wave_sum(lv[ln] * lv[64 + ln]), s23 = wave_sum(lv[128 + ln] * lv[192 + ln]); lam = expf(s01) - expf(s23) + lam_init; }
                LAS float* gsl = (LAS float*)(F.lds + TAB_OFF);
                if (F.tid < 128) gsl[F.tid] = FIN(I_ASUBLN)[(size_t)l * 128 + F.tid] * (1.0f - lam_init);
                LAS float* ktab = gsl + 128;
                if (F.tid >= 128 && F.tid < 256) ktab[F.tid - 128] = __uint_as_float(__hip_atomic_load(F.ctl + CW_KMAX + ((l * BATCH * 16) + ((F.tid - 128) >> 1)) * 16 + ((F.tid - 128) & 1), RLX_AGENT));
                constexpr int AQ_N = 224;
                const int xcc = __builtin_amdgcn_readfirstlane((int)(xb_xcc_id() & 7u));
                int kq = 0, qx = xcc, qmask = 0xff;
                if (F.tid == 0) F.MISC[240] = __hip_atomic_fetch_add(F.ctl + CW_AQ + 64 * (8 * l + qx), 1u, RLX_AGENT);
                __syncthreads();
                int cur = __builtin_amdgcn_readfirstlane((int)F.MISC[240]), ucount = 0;
                __syncthreads();
                for (;;) {
                    if (cur >= AQ_N && kq == 0) {
                        if (F.tid < 64) { int t8 = F.tid; asm volatile("" : "+v"(t8));
                            const unsigned hq = (t8 < 8) ? __hip_atomic_load(F.ctl + CW_AQ + 64 * (8 * l + ((xcc + t8) & 7)), RLX_AGENT) : 0xffffffffu;
                            const unsigned long long bal = __ballot(hq < (unsigned)AQ_N); if (F.tid == 0) F.MISC[244] = (unsigned)bal; }
                        __syncthreads(); qmask = __builtin_amdgcn_readfirstlane((int)F.MISC[244]); __syncthreads();
                    }
                    while (cur >= AQ_N && kq < 7) {
                        ++kq; if (!((qmask >> kq) & 1)) continue; qx = (xcc + kq) & 7;
                        if (F.tid == 0) F.MISC[240] = __hip_atomic_fetch_add(F.ctl + CW_AQ + 64 * (8 * l + qx), 1u, RLX_AGENT);
                        __syncthreads();
                        cur = __builtin_amdgcn_readfirstlane((int)F.MISC[240]);
                        __syncthreads();
                    }
                    if (cur >= AQ_N) break;
                    if (cur < 192 && (cur & 1)) {
                        expert_conv_unit(F, l, qx * 96 + (cur >> 1));
                        __syncthreads();
                        if (F.tid == 0) F.MISC[240] = __hip_atomic_fetch_add(F.ctl + CW_AQ + 64 * (8 * l + qx), 1u, RLX_AGENT);
                        __syncthreads();
                        cur = __builtin_amdgcn_readfirstlane((int)F.MISC[240]);
                        __syncthreads();
                        continue;
                    }
                    const int aidx = (cur < 192) ? (cur >> 1) : cur - 96;
                    int b, head, qb; att::unit_of_Aq(qx, aidx, b, head, qb);
                    const float s2 = LOG2E * __builtin_amdgcn_exp2f(-(float)(head + 1));
                    for (int r = 0; r < 2; ++r) {
                        const att::Tensors Tn{WSP(const bf16, WS_Q), WSP(const bf16, WS_K), WSP(const bf16, WS_V), WSP(bf16, WS_OC)};
                        const float kmax = sqrtf(ktab[(b * 16 + head * 2 + r) * 2] + ktab[(b * 16 + head * 2 + r) * 2 + 1]);
                        att::attn_unit<0, MK_A_EARLY>(Tn, b, head * 128 + r * 64, head * 128 + r * 64, head * 128, head * 128, qb, s2, kmax, ucount, wave0, (LAS char*)(F.lds + RING_OFF), r, lam, (const float*)gsl);
                        ++ucount;
                    }
                    if (F.tid == 0) F.MISC[240] = __hip_atomic_fetch_add(F.ctl + CW_AQ + 64 * (8 * l + qx), 1u, RLX_AGENT);
                    __syncthreads();
                    cur = __builtin_amdgcn_readfirstlane((int)F.MISC[240]);
                    __syncthreads();
                }
            } else if (!isA && !(MK_DIS & 16)) {
                const int xcc = __builtin_amdgcn_readfirstlane((int)(xb_xcc_id() & 7u));
                int ucount = 0;
                int qmask = 0xff;
                for (int kq = 0; kq < 8; ++kq) {
                    if (kq == 1) {
                        if (F.tid < 64) { const unsigned hq = (F.tid < 8) ? __hip_atomic_load(F.ctl + CW_AQ + 64 * (16 * l + ((xcc + F.tid) & 7)), RLX_AGENT) : 0xffffffffu;
                            const unsigned long long bal = __ballot(hq < 256u); if (F.tid == 0) F.MISC[244] = (unsigned)bal; }
                        __syncthreads(); qmask = __builtin_amdgcn_readfirstlane((int)F.MISC[244]); __syncthreads();
                    }
                    if (!((qmask >> kq) & 1)) continue;
                    const int qx = (xcc + kq) & 7; int cur;
                    if (F.tid == 0) F.MISC[240] = __hip_atomic_fetch_add(F.ctl + CW_AQ + 64 * (16 * l + qx), 1u, RLX_AGENT);
                    __syncthreads(); cur = __builtin_amdgcn_readfirstlane((int)F.MISC[240]); __syncthreads();
                    while (cur < 256) {
                        unsigned nxt = 0u; if (F.tid == 0) nxt = __hip_atomic_fetch_add(F.ctl + CW_AQ + 64 * (16 * l + qx), 1u, RLX_AGENT);
                        const int inst = qx * 8 + (cur >> 5), qb = 31 - (cur & 31), b = inst >> 4, h = inst & 15;
                        const att::Tensors Tn{WSP(const bf16, WS_Q), WSP(const bf16, WS_KSH), WSP(const bf16, WS_VSH), WSP(bf16, WS_O0)};
                        att::attn_unit<1, MK_SB_EARLY>(Tn, b, h * 64, h * 64, h * 64, h * 64, qb, 0.f, 0.f, ucount, wave0, (LAS char*)(F.lds + RING_OFF));
                        ++ucount;
                        if (F.tid == 0) F.MISC[240] = nxt;
                        __syncthreads(); cur = __builtin_amdgcn_readfirstlane((int)F.MISC[240]); __syncthreads();
                    }
                }
            }
            __syncthreads();
        }
        SEAM(sb + 3);
        if (IN(sb + 5) && !(MK_DIS & 64)) {
            pg8::Gemm g{isA ? WSP(const bf16, WS_OC) : WSP(const bf16, WS_O0), isA ? WSP(const bf16, WS_WOA) + (size_t)l * D * D : WSP(const bf16, WS_WOB) + (size_t)(l - 2) * D * D, T, D, D};
            pg8::StaticOrder S; S.init(T, D, F.G, cid);
            pg8::EpiResid E{(l == 0) ? FIN(I_X) : (const float*)nullptr, WSP(const unsigned short, WS_XCUR), WSP(unsigned short, WS_XCUR), WSP(const float, WS_MOD) + (size_t)l * BATCH * 6 * D + 2 * D, 6 * D, SEQ, D};
            if (MK_REP & 64) { pg8::EpiResid E2{(l == 0) ? FIN(I_X) : (const float*)nullptr, WSP(const unsigned short, WS_XCUR), WSP(unsigned short, WS_ACT), WSP(const float, WS_MOD) + (size_t)l * BATCH * 6 * D + 2 * D, 6 * D, SEQ, D};
                pg8::gemm_phase<pg8::EpiResid, pg8::StaticOrder, true, true>(F.lds + RING_OFF, g, S, E2, wave0); __syncthreads(); }
            pg8::gemm_phase<pg8::EpiResid, pg8::StaticOrder, true, true>(F.lds + RING_OFF, g, S, E, wave0);
        }
        SEAM(sb + 5);
        if ((MK_REP & 128) && IN(sb + 6)) { REFRESH(); router_pass(F, l, true); }
        if (IN(sb + 6) && !(MK_DIS & 128)) { REFRESH(); router_pass(F, l); }
        SEAM(sb + 6);
        for (int rep = 0; rep < ((MK_REP & 512) ? 2 : 1); ++rep)
        if (IN(sb + 8) && !(MK_DIS & 512)) {
            REFRESH(); moe_offsets(F, l);
            if (rep == 0) slot_rows_pass(F, l);
            pg8::Gemm g{(const bf16*)WSP(const unsigned char, WS_H), (const bf16*)(WSP(const unsigned char, WS_WGU) + (size_t)l * NE * 2 * D * D), XG_ROWS, NE * 2 * D, D / 2};
            pg8::GroupedOrder S{(const LAS int*)(F.lds + MISC_OFF), 8, F.G, cid, TOK_CAP};
            pg8::EpiSwiglu E{WSP(unsigned char, WS_ACT), FIN(I_BGU) + (size_t)l * NE * 2 * D};
            pg8::gemm_phase<pg8::EpiSwiglu, pg8::GroupedOrder, true, true, true, true>(F.lds + RING_OFF, g, S, E, wave0, WSP(const int, WS_XG), (LAS int*)(F.lds + TAB_OFF));
        }
        SEAM(sb + 8);
        for (int rep = 0; rep < ((MK_REP & 1024) ? 2 : 1); ++rep)
        if (IN(sb + 9) && !(MK_DIS & 1024)) {
            REFRESH(); moe_offsets(F, l);
            pg8::Gemm g{(const bf16*)WSP(const unsigned char, WS_ACT), (const bf16*)(WSP(const unsigned char, WS_WD) + (size_t)l * NE * D * D), XG_ROWS, NE * D, D / 2};
            pg8::GroupedOrder S{(const LAS int*)(F.lds + MISC_OFF), 4, F.G, cid, TOK_CAP};
            pg8::EpiDown E{WSP(unsigned char, WS_YS), FIN(I_BD) + (size_t)l * NE * D, WSP(const float, WS_RGATE)};
            pg8::gemm_phase<pg8::EpiDown, pg8::GroupedOrder, true, true, true>(F.lds + RING_OFF, g, S, E, wave0);
        }
        SEAM(sb + 9);
    }
    { int lo_ = lo, hi_ = hi; asm volatile("" : "+s"(lo_), "+s"(hi_));
      if (lo_ <= N_STEPS - 1 && N_STEPS - 1 < hi_) { REFRESH(); norm_combine_pass8(F, DEPTH); } }
#undef IN
#undef SEAM
}

extern "C" void kernel_launch(void* const* d_in, const int* in_sizes, int n_in, void* d_out, int out_size, void* d_ws, size_t ws_size, hipStream_t stream) {
    static int grid = 0;
    if (grid == 0) {
        if (n_in != 23 || in_sizes[0] != T * D || out_size != T * D || ws_size < WS_END) { fprintf(stderr, "kernel_launch: unexpected shapes / workspace (n_in %d, in0 %d, out %d, ws %zu < %zu); nothing launched\n", n_in, n_in > 0 ? in_sizes[0] : -1, out_size, ws_size, (size_t)WS_END); grid = -1; return; }
        int dev = 0, cus = 0, per_cu = 0;
        if (hipGetDevice(&dev) != hipSuccess || hipDeviceGetAttribute(&cus, hipDeviceAttributeMultiprocessorCount, dev) != hipSuccess) { fprintf(stderr, "kernel_launch: device query failed\n"); grid = -1; return; }
        if (hipFuncSetAttribute((const void*)mk_fwd, hipFuncAttributeMaxDynamicSharedMemorySize, LDS_BYTES) != hipSuccess) { fprintf(stderr, "kernel_launch: hipFuncSetAttribute failed\n"); grid = -1; return; }
        if (hipOccupancyMaxActiveBlocksPerMultiprocessor(&per_cu, (const void*)mk_fwd, NWAVES * 64, LDS_BYTES) != hipSuccess || per_cu < 1) { fprintf(stderr, "kernel_launch: occupancy query reports %d workgroups per CU\n", per_cu); }
        (void)hipGetLastError();
        grid = cus;
    }
    if (grid < 0) return;
    if (hipMemsetAsync((char*)d_ws + WS_CTL, 0, CTL_ZERO_BYTES, stream) != hipSuccess) { fprintf(stderr, "kernel_launch: memset failed\n"); return; }
    Args a{};
    for (int i = 0; i < 23; ++i) a.in[i] = (const float*)d_in[i];
    a.out = (float*)d_out; a.ws = (unsigned char*)d_ws;
#if MK_PER_STEP
    for (int s = 0; s < N_STEPS; ++s) { a.st_lo = s; a.st_hi = s + 1; hipLaunchKernelGGL(mk_fwd, dim3(grid), dim3(NWAVES * 64), LDS_BYTES, stream, a); }
#else
    a.st_lo = 0; a.st_hi = N_STEPS; hipLaunchKernelGGL(mk_fwd, dim3(grid), dim3(NWAVES * 64), LDS_BYTES, stream, a);
#endif
    const hipError_t le = hipPeekAtLastError();
    if (le != hipSuccess) fprintf(stderr, "kernel_launch: launch failed: %s\n", hipGetErrorName(le));
}
```

```cpp
#include <hip/hip_runtime.h>
#include <hip/hip_bf16.h>
#include <cstdio>
#include <cstdint>
#include <cmath>

namespace pg8 {
#define PG8_LAS __attribute__((address_space(3)))
typedef unsigned short bf16_t;
typedef short bf16x8 __attribute__((ext_vector_type(8)));
typedef float f32x4 __attribute__((ext_vector_type(4)));
typedef unsigned u32x4 __attribute__((ext_vector_type(4)));
typedef int v4i_t __attribute__((ext_vector_type(4)));
typedef unsigned u32x2 __attribute__((ext_vector_type(2)));
constexpr int BM = 256, BK = 64, HALF = 128, HTB = HALF * BK * 2  , STAGE_BYTES = 8 * HTB, NXCD = 8, WGM = 8;

__host__ __device__ __forceinline__ int lds_byte(int r, int c) { const int st = (r >> 4) * 2 + (c >> 5), rr = r & 15, cc = c & 31, ob = rr * 64 + cc * 2; return st * 1024 + (ob ^ (((ob >> 9) & 1) << 5)); }
__host__ __device__ __forceinline__ void stage_rc(int b, int& R, int& C) { const int st = b / 1024, sb = b % 1024, swz = sb ^ (((sb >> 9) & 1) << 5); R = (st >> 1) * 16 + swz / 64; C = (st & 1) * 32 + (swz % 64) / 2; }
__host__ __device__ __forceinline__ int perm32(int rho) { const int n = rho >> 4, i = rho & 15; return 8 * (i >> 2) + 4 * n + (i & 3); }

struct Unit { int pm, pn, gl; };
struct Gemm { const bf16_t* A; const bf16_t* Bt; int M, N, K; };

struct StaticOrder {
    int nM, nN, nwg, G, c;
    __host__ __device__ void init(int M, int N, int G_, int c_) { nM = M / BM; nN = N / BM; nwg = nM * nN; G = G_; c = c_; }
    __host__ __device__ bool next(int i, Unit& u) const {
        const long L = (long)i * G + c; if (L >= nwg) return false;
        int wgid = (int)L; { const int q = nwg / NXCD, r = nwg % NXCD, xcd = wgid % NXCD, off = wgid / NXCD; wgid = (xcd < r ? xcd * (q + 1) : r * (q + 1) + (xcd - r) * q) + off; }
        const int nig = WGM * nN, gid = wgid / nig, fm = gid * WGM, gsz = (nM - fm) < WGM ? (nM - fm) : WGM;
        u.pm = fm + ((wgid % nig) % gsz); u.pn = (wgid % nig) / gsz; return true;
    }
    __device__ __forceinline__ void a_ready(const Unit&) const {}
    __device__ __forceinline__ void done(const Unit&) const {}
};


typedef float f32x2 __attribute__((ext_vector_type(2)));
__device__ __forceinline__ unsigned cvt_pk_bf16(float lo, float hi) { unsigned r; asm volatile("v_cvt_pk_bf16_f32 %0, %1, %2" : "=v"(r) : "v"(lo), "v"(hi)); return r; }
__device__ __forceinline__ unsigned cvt_pk4_fp8(float a, float b, float c, float d) { int r = __builtin_amdgcn_cvt_pk_fp8_f32(a, b, 0, false); r = __builtin_amdgcn_cvt_pk_fp8_f32(c, d, r, true); return (unsigned)r; }
constexpr float W8_SCALE = 256.0f, W8_INV = 1.0f / 256.0f;
struct EpiBf16 {
    static constexpr bool PERM = true, AFTER_DRAIN = false;
    bf16_t* O; int ldc; int split_cols; size_t split_stride; float scale0; unsigned* kmaxw; int rows_per_batch;
    __device__ __forceinline__ void operator()(const f32x4 (&acc)[2][2][4][2], const Unit& u, int wr, int wc, int fr, int fq) const {
        const int row0 = u.pm * BM + wr * 64 + fr; int colt = u.pn * BM; bf16_t* base = O;
        float sc = 1.f; int tsel = 0; if (split_cols) { const int t = colt / split_cols; tsel = t; base += (size_t)t * split_stride; colt -= t * split_cols; if (t == 0) sc = scale0; }
        const int col0 = colt + wc * 32 + 8 * fq;
        const bool dok = (kmaxw != nullptr) && (tsel == 1);
        float mx[2] = {0.f, 0.f};
#pragma unroll
        for (int ai = 0; ai < 2; ++ai)
#pragma unroll
            for (int m = 0; m < 4; ++m) { bf16_t* rowp = base + (size_t)(row0 + ai * HALF + m * 16) * ldc + col0;
#pragma unroll
                for (int bj = 0; bj < 2; ++bj) { f32x4 v0 = acc[ai][bj][m][0] * sc, v1 = acc[ai][bj][m][1] * sc;
                    u32x4 w; w.x = cvt_pk_bf16(v0[0], v0[1]); w.y = cvt_pk_bf16(v0[2], v0[3]); w.z = cvt_pk_bf16(v1[0], v1[1]); w.w = cvt_pk_bf16(v1[2], v1[3]);
                    *(u32x4*)(rowp + bj * HALF) = w;
                    if (dok) { float s = 0.f;
#pragma unroll
                        for (int k = 0; k < 4; ++k) { const float a = __uint_as_float(w[k] << 16), b = __uint_as_float(w[k] & 0xffff0000u); s += a * a + b * b; }
                        s += __shfl_xor(s, 16); s += __shfl_xor(s, 32); mx[bj] = fmaxf(mx[bj], s); } } }
        if (dok) {
#pragma unroll
            for (int bj = 0; bj < 2; ++bj) { float s = mx[bj]; s = fmaxf(s, __shfl_xor(s, 1)); s = fmaxf(s, __shfl_xor(s, 2)); s = fmaxf(s, __shfl_xor(s, 4)); s = fmaxf(s, __shfl_xor(s, 8));
                if (fr == 0 && fq == 0) { const int cl = colt + bj * HALF + wc * 32; __hip_atomic_fetch_max(kmaxw + (((u.pm * BM) / rows_per_batch) * 16 + (cl >> 6)) * 16 + ((cl >> 5) & 1), __float_as_uint(s), __ATOMIC_RELAXED, __HIP_MEMORY_SCOPE_AGENT); } }
        }
    }
};
struct EpiResid {
    static constexpr bool PERM = true, AFTER_DRAIN = false;
    const float* Xin32; const unsigned short* Xin; unsigned short* Xout; const float* g; int gstride; int rows_per_batch; int ldc;
    __device__ __forceinline__ void operator()(const f32x4 (&acc)[2][2][4][2], const Unit& u, int wr, int wc, int fr, int fq) const {
        const int row0 = u.pm * BM + wr * 64 + fr, col0 = u.pn * BM + wc * 32 + 8 * fq;
        const int b = (u.pm * BM) / rows_per_batch;
        f32x4 gv[2][2];
#pragma unroll
        for (int bj = 0; bj < 2; ++bj)
#pragma unroll
            for (int n = 0; n < 2; ++n) gv[bj][n] = *(const f32x4*)(g + (size_t)b * gstride + col0 + bj * HALF + 4 * n);
        if (Xin32) {
#pragma unroll
            for (int ai = 0; ai < 2; ++ai)
#pragma unroll
                for (int m = 0; m < 4; ++m) { const size_t off = (size_t)(row0 + ai * HALF + m * 16) * ldc + col0;
#pragma unroll
                    for (int bj = 0; bj < 2; ++bj) { const f32x4 x0 = *(const f32x4*)(Xin32 + off + bj * HALF) + gv[bj][0] * acc[ai][bj][m][0], x1 = *(const f32x4*)(Xin32 + off + bj * HALF + 4) + gv[bj][1] * acc[ai][bj][m][1];
                        u32x4 w; w.x = cvt_pk_bf16(x0[0], x0[1]); w.y = cvt_pk_bf16(x0[2], x0[3]); w.z = cvt_pk_bf16(x1[0], x1[1]); w.w = cvt_pk_bf16(x1[2], x1[3]);
                        *(u32x4*)(Xout + off + bj * HALF) = w; } }
        } else {
#pragma unroll
            for (int ai = 0; ai < 2; ++ai)
#pragma unroll
                for (int m = 0; m < 4; ++m) { const size_t off = (size_t)(row0 + ai * HALF + m * 16) * ldc + col0;
#pragma unroll
                    for (int bj = 0; bj < 2; ++bj) { const u32x4 r = *(const u32x4*)(Xin + off + bj * HALF);
                        const f32x4 x0 = (f32x4){__uint_as_float(r.x << 16), __uint_as_float(r.x & 0xffff0000u), __uint_as_float(r.y << 16), __uint_as_float(r.y & 0xffff0000u)} + gv[bj][0] * acc[ai][bj][m][0];
                        const f32x4 x1 = (f32x4){__uint_as_float(r.z << 16), __uint_as_float(r.z & 0xffff0000u), __uint_as_float(r.w << 16), __uint_as_float(r.w & 0xffff0000u)} + gv[bj][1] * acc[ai][bj][m][1];
                        u32x4 w; w.x = cvt_pk_bf16(x0[0], x0[1]); w.y = cvt_pk_bf16(x0[2], x0[3]); w.z = cvt_pk_bf16(x1[0], x1[1]); w.w = cvt_pk_bf16(x1[2], x1[3]);
                        *(u32x4*)(Xout + off + bj * HALF) = w; } }
        }
    }
};
struct EpiSwiglu {
    static constexpr bool PERM = true, AFTER_DRAIN = false;
    unsigned char* ACT; const float* bgu;
    __device__ __forceinline__ void operator()(const f32x4 (&acc)[2][2][4][2], const Unit& u, int wr, int wc, int fr, int fq) const {
        const int e = u.pn >> 3, nt = u.pn & 7;
        const int row0 = u.pm * BM + wr * 64 + fr, j0 = nt * HALF + wc * 32 + 8 * fq;
        const float* bb = bgu + (size_t)e * 2048 + j0;
        f32x4 bg[2], bu[2];
#pragma unroll
        for (int n = 0; n < 2; ++n) { bg[n] = *(const f32x4*)(bb + 4 * n); bu[n] = *(const f32x4*)(bb + 1024 + 4 * n); }
        f32x2 bgp[4], bup[4];
        constexpr float SWC = -1.702f * 1.4426950408889634f, SWI = 1.0f / SWC;
#pragma unroll
        for (int n = 0; n < 2; ++n) { bgp[2 * n] = (f32x2){bg[n][0], bg[n][1]} * SWC; bgp[2 * n + 1] = (f32x2){bg[n][2], bg[n][3]} * SWC; bup[2 * n] = (f32x2){bu[n][0] + 1.0f, bu[n][1] + 1.0f} * SWI; bup[2 * n + 1] = (f32x2){bu[n][2] + 1.0f, bu[n][3] + 1.0f} * SWI; }
#pragma unroll
        for (int ai = 0; ai < 2; ++ai)
#pragma unroll
            for (int m = 0; m < 4; ++m) {
                f32x2 rr[4];
#pragma unroll
                for (int h = 0; h < 4; ++h) { const int n = h >> 1, k = (h & 1) * 2;
                    f32x2 t = (f32x2){acc[ai][0][m][n][k], acc[ai][0][m][n][k + 1]} * (W8_INV * SWC) + bgp[h];
                    f32x2 u2 = (f32x2){acc[ai][1][m][n][k], acc[ai][1][m][n][k + 1]} * (W8_INV * SWI) + bup[h];
                    t.x = fmaxf(t.x, 7.0f * SWC); t.y = fmaxf(t.y, 7.0f * SWC);
                    u2.x = __builtin_amdgcn_fmed3f(u2.x, 8.0f * SWI, -6.0f * SWI); u2.y = __builtin_amdgcn_fmed3f(u2.y, 8.0f * SWI, -6.0f * SWI);
                    f32x2 e; e.x = __builtin_amdgcn_exp2f(t.x); e.y = __builtin_amdgcn_exp2f(t.y);
                    e = e + 1.0f;
                    f32x2 s; s.x = __builtin_amdgcn_rcpf(e.x); s.y = __builtin_amdgcn_rcpf(e.y);
                    rr[h] = (t * u2) * s; }
                u32x2 w; w.x = cvt_pk4_fp8(rr[0].x, rr[0].y, rr[1].x, rr[1].y); w.y = cvt_pk4_fp8(rr[2].x, rr[2].y, rr[3].x, rr[3].y);
                *(u32x2*)(ACT + (size_t)(row0 + ai * HALF + m * 16) * 1024 + j0) = w; }
    }
};
constexpr float YS_SCALE = 4.0f, YS_INV = 1.0f / 4.0f;
struct EpiDown {
    static constexpr bool PERM = true, AFTER_DRAIN = false;
    unsigned char* YS; const float* bd; const float* rgate;
    __device__ __forceinline__ void operator()(const f32x4 (&acc)[2][2][4][2], const Unit& u, int wr, int wc, int fr, int fq) const {
        const int e = u.pn >> 2, nt = u.pn & 3;
        const int row0 = u.pm * BM + wr * 64 + fr, col0 = nt * BM + wc * 32 + 8 * fq;
        f32x4 bv[2][2];
#pragma unroll
        for (int bj = 0; bj < 2; ++bj)
#pragma unroll
            for (int n = 0; n < 2; ++n) bv[bj][n] = *(const f32x4*)(bd + (size_t)e * 1024 + col0 + bj * HALF + 4 * n) * YS_SCALE;
#pragma unroll
        for (int ai = 0; ai < 2; ++ai)
#pragma unroll
            for (int m = 0; m < 4; ++m) { const int row = row0 + ai * HALF + m * 16; unsigned char* rowp = YS + (size_t)row * 1024 + col0;
#pragma unroll
                for (int bj = 0; bj < 2; ++bj) { const f32x4 v0 = acc[ai][bj][m][0] * (W8_INV * YS_SCALE) + bv[bj][0], v1 = acc[ai][bj][m][1] * (W8_INV * YS_SCALE) + bv[bj][1];
                    u32x2 w; w.x = cvt_pk4_fp8(v0[0], v0[1], v0[2], v0[3]); w.y = cvt_pk4_fp8(v1[0], v1[1], v1[2], v1[3]);
                    *(u32x2*)(rowp + bj * HALF) = w; } }
    }
};
struct GroupedOrder {
    const PG8_LAS int* P; int nN, G, c, cap;
    __device__ __forceinline__ bool next(int i, Unit& u) const {
        int mt, nt;
        if (G == 256) { const int x = c & 7, j = c >> 3, mpx = 32 / nN; mt = i * (8 * mpx) + x * mpx + j / nN; nt = j % nN; }
        else { const long L = (long)i * G + c; mt = (int)(L / nN); nt = (int)(L % nN); }
        if (mt >= P[32]) return false;
        const int ln = (int)__builtin_amdgcn_mbcnt_hi(~0u, __builtin_amdgcn_mbcnt_lo(~0u, 0u)) & 31; const int pl_ = P[ln], pn_ = P[ln + 1];
        int e = (int)__builtin_ctzll(__ballot(pl_ <= mt && mt < pn_) | (1ull << 63)) & 31;
        e = __builtin_amdgcn_readfirstlane(e); u.pm = mt; u.pn = e * nN + nt; u.gl = e * cap + (mt - P[e]) * BM; u.gl = __builtin_amdgcn_readfirstlane(u.gl); return true;
    }
    __device__ __forceinline__ void a_ready(const Unit&) const {}
    __device__ __forceinline__ void done(const Unit&) const {}
};

template <class Epi, class Sched, bool ALIGN_EPI = false, bool SP2 = false, bool F8 = false, bool GATHER = false>
__device__ __forceinline__ void gemm_phase(PG8_LAS unsigned char* lds, const Gemm g, const Sched& S, const Epi& E, int wave_id, const int* rowlist = nullptr, PG8_LAS int* tokl = nullptr) {
    int tid_; asm volatile("v_mbcnt_lo_u32_b32 %0, -1, 0\n\tv_mbcnt_hi_u32_b32 %0, -1, %0\n\tv_lshl_add_u32 %0, %1, 6, %0" : "=&v"(tid_) : "s"(wave_id));
    const int tid = tid_, wid = __builtin_amdgcn_readfirstlane(tid >> 6), lane = tid & 63, wr = wid >> 2, wc = wid & 3, fr = lane & 15, fq = lane >> 4;
    static_assert(!GATHER || SP2, "the gathered-A path is written for the two-super-phase loop");
    const int K = g.K, nt = K / BK;
    unsigned voffA[2], voffB[2]; int rowA[2]; unsigned colA[2];
#pragma unroll
    for (int i = 0; i < 2; ++i) { int R, C; stage_rc(tid * 16 + i * 8192, R, C); const int Rb = Epi::PERM ? ((R & ~31) + perm32(R & 31)) : R;
        voffA[i] = (unsigned)(R * K + C) * 2u; voffB[i] = (unsigned)(Rb * K + C) * 2u; rowA[i] = R; colA[i] = (unsigned)C * 2u; }
    unsigned vG[2][2] = {{0u, 0u}, {0u, 0u}}, vGn[2][2] = {{0u, 0u}, {0u, 0u}};
#define PG8_TOKFETCH(u_, par_) do { if (wid < 4) { int ln_ = lane; asm volatile("" : "+v"(ln_));   \
        __builtin_amdgcn_global_load_lds((const unsigned*)(rowlist + (u_).gl + 64 * wid + ln_), (PG8_LAS unsigned*)(tokl + (par_) * 256 + 64 * wid), 4, 0, 0); } } while (0)
#define PG8_TOKREAD(dst_, par_) do { _Pragma("unroll") for (int h_ = 0; h_ < 2; ++h_) _Pragma("unroll") for (int i_ = 0; i_ < 2; ++i_) dst_[h_][i_] = (unsigned)(tokl[(par_) * 256 + h_ * HALF + rowA[i_]] & 0x7fff) * (unsigned)(K * 2) + colA[i_]; } while (0)
#define PG8_STAGE_A(bufoff, ptr, h_, nx_) do { if constexpr (GATHER) { unsigned vo_[2]; vo_[0] = (nx_) ? vGn[h_][0] : vG[h_][0]; vo_[1] = (nx_) ? vGn[h_][1] : vG[h_][1]; PG8_STAGE(bufoff, ptr, vo_); } \
        else { PG8_STAGE(bufoff, (ptr) + (h_) * hstep, voffA); } } while (0)
    const size_t kstep = (size_t)(BK * 2);
    const size_t hstep = (size_t)HALF * K * 2;
    const size_t tstep = 2 * hstep;
    const unsigned ldsw = (unsigned)wid * 1024u;
    const int aoff = lds_byte(wr * 64 + fr, fq * 8), boff = lds_byte(wc * 32 + fr, fq * 8);
#define PG8_SA(b, h) (((b) * 2 + (h)) * HTB)
#define PG8_SB(b, h) ((4 + (b) * 2 + (h)) * HTB)
#define PG8_STAGE(bufoff, gbase, voff) do { _Pragma("unroll") for (int _i = 0; _i < 2; ++_i) \
        __builtin_amdgcn_global_load_lds((const unsigned*)((const char*)(gbase) + (voff)[_i]), (PG8_LAS unsigned*)(lds + (bufoff) + ldsw + _i * 8192), 16, 0, 0); } while (0)
#define PG8_LDA(dst, b, h) do { _Pragma("unroll") for (int m = 0; m < 4; ++m) _Pragma("unroll") for (int k = 0; k < 2; ++k) dst[m][k] = *(const PG8_LAS bf16x8*)(lds + PG8_SA(b, h) + aoff + m * 2048 + k * 1024); } while (0)
#define PG8_LDB(dst, b, h) do { _Pragma("unroll") for (int n = 0; n < 2; ++n) _Pragma("unroll") for (int k = 0; k < 2; ++k) dst[n][k] = *(const PG8_LAS bf16x8*)(lds + PG8_SB(b, h) + boff + n * 2048 + k * 1024); } while (0)
#define PG8_CAT(x0, x1) __builtin_shufflevector(__builtin_bit_cast(v4i_t, x0), __builtin_bit_cast(v4i_t, x1), 0, 1, 2, 3, 4, 5, 6, 7)
#define PG8_MMA(ai, bj, At, Bt) do { __builtin_amdgcn_s_setprio(1); _Pragma("unroll") for (int m = 0; m < 4; ++m) _Pragma("unroll") for (int n = 0; n < 2; ++n) { \
        if constexpr (F8) asm volatile("v_mfma_scale_f32_16x16x128_f8f6f4 %0, %1, %2, %0, %3, %3 op_sel_hi:[0,0,0]" : "+v"(acc[ai][bj][m][n]) : "v"(PG8_CAT(Bt[n][0], Bt[n][1])), "v"(PG8_CAT(At[m][0], At[m][1])), "v"(f8scale)); \
        else { _Pragma("unroll") for (int k = 0; k < 2; ++k) acc[ai][bj][m][n] = __builtin_amdgcn_mfma_f32_16x16x32_bf16(Bt[n][k], At[m][k], acc[ai][bj][m][n], 0, 0, 0); } } __builtin_amdgcn_s_setprio(0); } while (0)
#define PG8_WAIT_V(n) asm volatile("s_waitcnt vmcnt(" #n ")" ::: "memory")
#define PG8_WAIT_L(n) asm volatile("s_waitcnt lgkmcnt(" #n ")" ::: "memory")
#define PG8_BAR __builtin_amdgcn_s_barrier()
#define PG8_SCHED __builtin_amdgcn_sched_barrier(0)
    const int f8scale = 0x7F7F7F7F;
    Unit cur, nxt; int ui = 0;
    if (!S.next(0, cur)) return;
    f32x4 acc[2][2][4][2];
#pragma unroll
    for (int a = 0; a < 2; ++a)
#pragma unroll
        for (int b = 0; b < 2; ++b)
#pragma unroll
            for (int m = 0; m < 4; ++m)
#pragma unroll
                for (int n = 0; n < 2; ++n) acc[a][b][m][n] = (f32x4){0.f, 0.f, 0.f, 0.f};
    bf16x8 At[4][2], B0[2][2], B1[2][2];
    const char* cA = GATHER ? (const char*)g.A : (const char*)g.A + (size_t)cur.pm * tstep; const char* cB = (const char*)g.Bt + (size_t)cur.pn * tstep;
    S.a_ready(cur);
    if constexpr (GATHER) { PG8_TOKFETCH(cur, 0); asm volatile("s_waitcnt vmcnt(0)" ::: "memory"); __builtin_amdgcn_s_barrier(); PG8_TOKREAD(vG, 0); asm volatile("s_waitcnt lgkmcnt(0)" ::: "memory"); }
    if constexpr (SP2) {
        PG8_STAGE(PG8_SB(0, 0), cB, voffB); PG8_STAGE(PG8_SB(0, 1), cB + hstep, voffB); PG8_STAGE_A(PG8_SA(0, 0), cA, 0, false); PG8_STAGE_A(PG8_SA(0, 1), cA, 1, false);
        if (wr == 1) PG8_BAR;
        PG8_WAIT_V(2); PG8_BAR;
        PG8_STAGE(PG8_SB(1, 0), cB + kstep, voffB); PG8_STAGE_A(PG8_SA(1, 0), cA + kstep, 0, false); PG8_STAGE(PG8_SB(1, 1), cB + hstep + kstep, voffB);
        PG8_WAIT_V(6); PG8_BAR;
    } else {
        PG8_STAGE(PG8_SB(0, 0), cB, voffB); PG8_STAGE(PG8_SA(0, 0), cA, voffA); PG8_STAGE(PG8_SB(0, 1), cB + hstep, voffB); PG8_STAGE(PG8_SA(0, 1), cA + hstep, voffA);
        if (wr == 1) PG8_BAR;
        PG8_WAIT_V(4); PG8_BAR;
        PG8_STAGE(PG8_SB(1, 0), cB + kstep, voffB); PG8_STAGE(PG8_SA(1, 0), cA + kstep, voffA); PG8_STAGE(PG8_SB(1, 1), cB + hstep + kstep, voffB);
        PG8_WAIT_V(6); PG8_BAR;
    }
    for (;;) {
        const bool has_next = S.next(ui + 1, nxt);
        const char* nA = GATHER ? cA : (has_next ? (const char*)g.A + (size_t)nxt.pm * tstep : cA); const char* nB = has_next ? (const char*)g.Bt + (size_t)nxt.pn * tstep : cB;
        if constexpr (GATHER) { if (has_next) PG8_TOKFETCH(nxt, (ui + 1) & 1); }
#pragma unroll 1
        for (int t = 0; t < nt; t += 2) {
            const bool last = (t == nt - 2);
            const char* a1 = cA + (size_t)(t + 1) * kstep;
            const char* a2 = last ? nA : cA + (size_t)(t + 2) * kstep; const char* b2 = last ? nB : cB + (size_t)(t + 2) * kstep;
            const char* a3 = a2 + kstep; const char* b3 = b2 + kstep;
            if (last && has_next) S.a_ready(nxt);
            if constexpr (GATHER) { if (last) { if (has_next) { PG8_TOKREAD(vGn, (ui + 1) & 1); } else { vGn[0][0] = vG[0][0]; vGn[0][1] = vG[0][1]; vGn[1][0] = vG[1][0]; vGn[1][1] = vG[1][1]; } } }
            if constexpr (SP2) {
            PG8_LDB(B0, 0, 0); PG8_LDB(B1, 0, 1); PG8_SCHED; PG8_LDA(At, 0, 0); PG8_STAGE_A(PG8_SA(1, 1), a1, 1, false);
            PG8_WAIT_V(8); PG8_WAIT_L(0); PG8_BAR; PG8_MMA(0, 0, At, B0); PG8_MMA(0, 1, At, B1); PG8_BAR; PG8_SCHED;
            PG8_LDA(At, 0, 1); PG8_STAGE(PG8_SB(0, 0), b2, voffB); PG8_STAGE(PG8_SB(0, 1), b2 + hstep, voffB); PG8_STAGE_A(PG8_SA(0, 0), a2, 0, last);
            PG8_WAIT_V(8); PG8_WAIT_L(0); PG8_BAR; PG8_MMA(1, 0, At, B0); PG8_MMA(1, 1, At, B1); PG8_BAR; PG8_SCHED;
            PG8_LDB(B0, 1, 0); PG8_LDB(B1, 1, 1); PG8_SCHED; PG8_LDA(At, 1, 0); PG8_STAGE_A(PG8_SA(0, 1), a2, 1, last);
            PG8_WAIT_V(8); PG8_WAIT_L(0); PG8_BAR; PG8_MMA(0, 0, At, B0); PG8_MMA(0, 1, At, B1); PG8_BAR; PG8_SCHED;
            PG8_LDA(At, 1, 1); PG8_STAGE(PG8_SB(1, 0), b3, voffB); PG8_STAGE(PG8_SB(1, 1), b3 + hstep, voffB); PG8_STAGE_A(PG8_SA(1, 0), a3, 0, last);
            PG8_WAIT_V(8); PG8_WAIT_L(0); PG8_BAR; PG8_MMA(1, 0, At, B0); PG8_MMA(1, 1, At, B1); PG8_BAR; PG8_SCHED;
            } else {
            PG8_LDB(B0, 0, 0); PG8_SCHED; PG8_LDA(At, 0, 0); PG8_STAGE(PG8_SA(1, 1), a1 + hstep, voffA);
            PG8_WAIT_L(8); PG8_BAR; PG8_WAIT_L(0); PG8_MMA(0, 0, At, B0); PG8_BAR; PG8_SCHED;
            PG8_LDB(B1, 0, 1); PG8_STAGE(PG8_SB(0, 0), b2, voffB);
            PG8_BAR; PG8_WAIT_L(0); PG8_MMA(0, 1, At, B1); PG8_BAR;
            PG8_LDA(At, 0, 1); PG8_STAGE(PG8_SA(0, 0), a2, voffA);
            PG8_BAR; PG8_WAIT_L(0); PG8_MMA(1, 0, At, B0); PG8_BAR; PG8_SCHED;
            PG8_STAGE(PG8_SB(0, 1), b2 + hstep, voffB);
            PG8_WAIT_V(6); PG8_BAR; PG8_MMA(1, 1, At, B1); PG8_BAR;
            PG8_LDB(B0, 1, 0); PG8_SCHED; PG8_LDA(At, 1, 0); PG8_STAGE(PG8_SA(0, 1), a2 + hstep, voffA);
            PG8_WAIT_L(8); PG8_BAR; PG8_WAIT_L(0); PG8_MMA(0, 0, At, B0); PG8_BAR; PG8_SCHED;
            PG8_LDB(B1, 1, 1); PG8_STAGE(PG8_SB(1, 0), b3, voffB);
            PG8_BAR; PG8_WAIT_L(0); PG8_MMA(0, 1, At, B1); PG8_BAR;
            PG8_LDA(At, 1, 1); PG8_STAGE(PG8_SA(1, 0), a3, voffA);
            PG8_BAR; PG8_WAIT_L(0); PG8_MMA(1, 0, At, B0); PG8_BAR; PG8_SCHED;
            PG8_STAGE(PG8_SB(1, 1), b3 + hstep, voffB);
            PG8_WAIT_V(6); PG8_BAR; PG8_MMA(1, 1, At, B1); PG8_BAR;
            }
        }
        if constexpr (ALIGN_EPI) { if (wr == 0) PG8_BAR; }
        if constexpr (F8) asm volatile("s_nop 15\n\ts_nop 15" ::: "memory");
        if constexpr (!Epi::AFTER_DRAIN) { int fr_ = fr, fq_ = fq; asm volatile("" : "+v"(fr_), "+v"(fq_));
            E(acc, cur, wr, wc, fr_, fq_); S.done(cur); }
        if (!has_next) break;
#pragma unroll
        for (int a = 0; a < 2; ++a)
#pragma unroll
            for (int b = 0; b < 2; ++b)
#pragma unroll
                for (int m = 0; m < 4; ++m)
#pragma unroll
                    for (int n = 0; n < 2; ++n) acc[a][b][m][n] = (f32x4){0.f, 0.f, 0.f, 0.f};
        cur = nxt; cA = nA; cB = nB; ++ui;
        if constexpr (GATHER) { vG[0][0] = vGn[0][0]; vG[0][1] = vGn[0][1]; vG[1][0] = vGn[1][0]; vG[1][1] = vGn[1][1]; }
        if constexpr (ALIGN_EPI) { if (wr == 1) PG8_BAR; }
    }
    PG8_WAIT_V(0);
    if constexpr (!ALIGN_EPI) { if (wr == 0) PG8_BAR; }
    PG8_BAR;
    if constexpr (Epi::AFTER_DRAIN) { E.fused(acc, cur, wr, wc, fr, fq, lds, wid, lane); S.done(cur); }
#undef PG8_SA
#undef PG8_SB
#undef PG8_STAGE
#undef PG8_STAGE_A
#undef PG8_TOKFETCH
#undef PG8_TOKREAD
#undef PG8_LDA
#undef PG8_LDB
#undef PG8_MMA
#undef PG8_CAT
#undef PG8_WAIT_V
#undef PG8_WAIT_L
#undef PG8_BAR
#undef PG8_SCHED
}
}


#define GAS __attribute__((address_space(1)))
#define LAS __attribute__((address_space(3)))
typedef unsigned short bf16;
typedef unsigned v4u __attribute__((ext_vector_type(4)));
typedef unsigned v2u __attribute__((ext_vector_type(2)));
typedef unsigned u32x4 __attribute__((ext_vector_type(4)));
typedef float f32x4 __attribute__((ext_vector_type(4)));
typedef float f32x16 __attribute__((ext_vector_type(16)));
typedef short bf16x8 __attribute__((ext_vector_type(8)));
typedef short s16x4 __attribute__((ext_vector_type(4)));
typedef GAS unsigned gu32;
#define RLX_AGENT __ATOMIC_RELAXED, __HIP_MEMORY_SCOPE_AGENT
#define LDS_WAIT() asm volatile("s_waitcnt lgkmcnt(0)" ::: "memory")
#define VM_WAIT() asm volatile("s_waitcnt vmcnt(0)" ::: "memory")
__device__ __forceinline__ unsigned pk2(float lo, float hi) { unsigned r; asm volatile("v_cvt_pk_bf16_f32 %0, %1, %2" : "=v"(r) : "v"(lo), "v"(hi)); return r; }
__device__ __forceinline__ unsigned pk4f8(float a, float b, float c, float d) { int r = __builtin_amdgcn_cvt_pk_fp8_f32(a, b, 0, false); r = __builtin_amdgcn_cvt_pk_fp8_f32(c, d, r, true); return (unsigned)r; }
typedef float f32x2g __attribute__((ext_vector_type(2)));
__device__ __forceinline__ f32x4 f8x4_to_f32(unsigned w) { const f32x2g lo = __builtin_amdgcn_cvt_pk_f32_fp8((int)w, false), hi = __builtin_amdgcn_cvt_pk_f32_fp8((int)w, true); return (f32x4){lo.x, lo.y, hi.x, hi.y}; }
__device__ __forceinline__ float bflo(unsigned w) { return __uint_as_float(w << 16); }
__device__ __forceinline__ float bfhi(unsigned w) { return __uint_as_float(w & 0xffff0000u); }
__device__ __forceinline__ float half_sum32(float v) {
#define WS_DPP(x_, c_) __int_as_float(__builtin_amdgcn_update_dpp(0, __float_as_int(x_), (c_), 0xf, 0xf, false))
    v += WS_DPP(v, 0xB1); v += WS_DPP(v, 0x4E); v += WS_DPP(v, 0x141); v += WS_DPP(v, 0x140);
#undef WS_DPP
    v += __int_as_float(__builtin_amdgcn_ds_swizzle(__float_as_int(v), 0x401F));
    return v;
}
__device__ __forceinline__ float wave_sum(float v) {
    v = half_sum32(v);
    auto rr = __builtin_amdgcn_permlane32_swap(__float_as_uint(v), __float_as_uint(v), false, false);
    return __uint_as_float(rr[0]) + __uint_as_float(rr[1]);
}

constexpr int BATCH = 4, SEQ = 8192, D = 1024, T = BATCH * SEQ, DEPTH = 4, NE = 32, TOPK = 4;
constexpr int XG_ROWS = T * TOPK + NE * 256;
constexpr float EPS = 1e-6f, LOG2E = 1.4426950408889634f;
constexpr float QSCALE = 0.125f * LOG2E;
constexpr int NWAVES = 8;

constexpr size_t MiB = 1u << 20;
constexpr size_t WS_CTL = 0, CTL_ZERO_BYTES = 128 * 1024;
constexpr size_t WS_MOD = 2 * MiB;
constexpr size_t WS_KVMOD = WS_MOD + (size_t)DEPTH * BATCH * 6 * D * 4;
constexpr size_t WS_SLOT_E = 3 * MiB, WS_SLOT_POS = WS_SLOT_E + (size_t)T * 16, WS_SLOT_GATE = WS_SLOT_POS + (size_t)T * 16, WS_SLOT_ROW = WS_SLOT_GATE + (size_t)T * 16, WS_RGATE = WS_SLOT_ROW + (size_t)T * 16;
static_assert(WS_RGATE + (size_t)XG_ROWS * 4 <= 8 * MiB, "routing tables");
constexpr int TOK_CAP = T + 256;
constexpr size_t WS_WQKV = 8 * MiB;
constexpr size_t WS_WOA = WS_WQKV + 12 * MiB;
constexpr size_t WS_WKV = WS_WOA + 4 * MiB;
constexpr size_t WS_WQB = WS_WKV + 4 * MiB;
constexpr size_t WS_WOB = WS_WQB + 4 * MiB;
constexpr size_t WS_WGU = WS_WOB + 4 * MiB;
constexpr size_t WS_WD = WS_WGU + 256 * MiB;
constexpr size_t WS_XCUR = WS_WD + 128 * MiB;
constexpr size_t WS_H = WS_XCUR + 128 * MiB;
constexpr size_t WS_HKV = WS_H + 64 * MiB;
constexpr size_t WS_Q = WS_HKV + 64 * MiB, WS_K = WS_Q + 64 * MiB, WS_V = WS_K + 64 * MiB;
constexpr size_t WS_KSH = WS_V + 64 * MiB, WS_VSH = WS_KSH + 64 * MiB;
constexpr size_t WS_O0 = WS_VSH + 64 * MiB, WS_O1 = WS_O0 + 64 * MiB, WS_OC = WS_O1 + 64 * MiB;
constexpr size_t WS_XG = WS_OC + 64 * MiB;
constexpr size_t WS_ACT = WS_XG + 136 * MiB;
constexpr size_t WS_YS = WS_ACT + 136 * MiB;
constexpr int MODN = DEPTH * BATCH * 6 * D + BATCH * 2 * D, MODS = 8;
constexpr size_t WS_MODP = WS_YS + 136 * MiB, WS_END = WS_MODP + 4 * MiB;
static_assert((size_t)MODS * MODN * 4 <= 4 * MiB, "modp");
static_assert((size_t)XG_ROWS * D <= 136 * MiB, "XG");
constexpr int CW_BAR = 4096;
constexpr int CW_CNT = 16384;
constexpr int CW_XRANK = 7680;
constexpr int CW_AQ = 8192;
constexpr int CW_KMAX = CW_CNT + DEPTH * NE * 64;
static_assert((CW_KMAX + 2 * BATCH * 16 * 16) * 4 <= (int)CTL_ZERO_BYTES, "CTL words inside the memset region");

constexpr int RING_OFF = 0, RING_BYTES = 131072;
constexpr int MISC_OFF = RING_BYTES;
constexpr int TAB_OFF = MISC_OFF + 1024;
constexpr int LDS_BYTES = 155648;

#define XB_TMO      128
#define XB_XCNT(j)  (256  + 64 * (j))
#define XB_XSUB(j)  (1280 + 64 * (j))
#define XB_XGEN(j)  (2304 + 64 * (j))
#define XB_TOP      3328
#define XB_TOPGEN   3392
#define XCD_BAR_WORDS 3456
#define XB_SPIN_CAP (1u << 18)

__device__ __forceinline__ unsigned xb_ld(unsigned* p)              { return __hip_atomic_load(p, __ATOMIC_RELAXED, __HIP_MEMORY_SCOPE_AGENT); }
__device__ __forceinline__ unsigned xb_add(unsigned* p, unsigned v) { return __hip_atomic_fetch_add(p, v, __ATOMIC_RELAXED, __HIP_MEMORY_SCOPE_AGENT); }
__device__ __forceinline__ unsigned xb_xcc_id() { return (unsigned)__builtin_amdgcn_s_getreg((3 << 11) | 20) & 0xFu; }
#define XB_SPIN(cond, bar) do { unsigned _sp = 0; while (cond) { __builtin_amdgcn_s_sleep(1); \
    if ((++_sp & 255u) == 0u) { if (xb_ld(&(bar)[XB_TMO])) break; if (_sp > XB_SPIN_CAP) { atomicAdd(&(bar)[XB_TMO], 1u); break; } } } } while (0)

struct XcdBarrier {
    unsigned* bar; unsigned x;
    volatile LAS unsigned* st;
};

__device__ __forceinline__ XcdBarrier xcd_barrier_post(unsigned* bar, volatile LAS unsigned* st) {
    XcdBarrier b; b.bar = bar; b.x = xb_xcc_id(); b.st = st;
    if (threadIdx.x == 0) (void)xb_add(&bar[XB_XCNT(b.x)], 1u);
    return b;
}
__device__ __forceinline__ void xcd_barrier_complete(unsigned* bar, unsigned x, unsigned& nloc, unsigned& nx) {
    const unsigned G = gridDim.x * gridDim.y * gridDim.z;
    unsigned sum, cnt, mine, sp = 0u;
    for (;;) {
        sum = 0u; cnt = 0u; mine = 0u;
#pragma unroll
        for (unsigned j = 0; j < 16; ++j) { const unsigned c = xb_ld(&bar[XB_XCNT(j)]); sum += c; cnt += (c > 0u) ? 1u : 0u; mine = (j == x) ? c : mine; }
        if (sum == G) break;
        __builtin_amdgcn_s_sleep(1);
        if ((++sp & 255u) == 0u) { if (xb_ld(&bar[XB_TMO])) break; if (sp > XB_SPIN_CAP) { atomicAdd(&bar[XB_TMO], 1u); break; } }
    }
    nloc = mine > 0u ? mine : 1u; nx = cnt > 0u ? cnt : 1u;
}

__device__ __forceinline__ void xcd_barrier(const XcdBarrier& b) {
    asm volatile("s_waitcnt vmcnt(0)" ::: "memory");
    __syncthreads();
    if (threadIdx.x == 0) {
        unsigned* bar = b.bar;
        __builtin_amdgcn_s_waitcnt(0);
        unsigned nloc = b.st[0], nx = b.st[1];
        if (nloc == 0u) { xcd_barrier_complete(bar, b.x, nloc, nx); b.st[0] = nloc; b.st[1] = nx; }
        const unsigned old = xb_add(&bar[XB_XSUB(b.x)], 1u);
        const unsigned gen = old / nloc;
        if (old + 1u == (gen + 1u) * nloc) {
            __builtin_amdgcn_fence(__ATOMIC_RELEASE, "agent");
            asm volatile("s_waitcnt vmcnt(0)" ::: "memory");
            const unsigned og = xb_add(&bar[XB_TOP], 1u);
            const unsigned tg = og / nx;
            if (og + 1u == (tg + 1u) * nx) xb_add(&bar[XB_TOPGEN], 1u);
            else XB_SPIN(xb_ld(&bar[XB_TOPGEN]) == tg, bar);
            __builtin_amdgcn_fence(__ATOMIC_ACQUIRE, "agent");
            xb_add(&bar[XB_XGEN(b.x)], 1u);
            asm volatile("s_waitcnt vmcnt(0)" ::: "memory");
        } else {
            XB_SPIN(xb_ld(&bar[XB_XGEN(b.x)]) == gen, bar);
            __builtin_amdgcn_fence(__ATOMIC_ACQUIRE, "agent");
            asm volatile("s_waitcnt vmcnt(0)" ::: "memory");
        }
    }
    __syncthreads();
}


namespace att {
constexpr int PITCH = 1024;
constexpr int L_K = 0, L_V = 16384, L_WS = 49152, L_FLAG = 51200, L_OST = 53248, L_END = L_OST + 65536;
static_assert(L_END <= 131072, "attention LDS");
typedef __attribute__((address_space(3))) const char* lds_cptr;
typedef short v4i16_t __attribute__((ext_vector_type(4)));
__device__ __forceinline__ int crow(int r, int hi) { return (r & 3) + 8 * (r >> 2) + 4 * hi; }
__device__ __forceinline__ void glds16(const void* gsrc, unsigned lds_dst) { unsigned keep;
    asm volatile("s_mov_b32 %0, m0\n\ts_mov_b32 m0, %2\n\ts_nop 0\n\tglobal_load_lds_dwordx4 %1, off\n\ts_mov_b32 m0, %0" : "=&s"(keep) : "v"(gsrc), "s"(lds_dst) : "memory"); }
__device__ __forceinline__ s16x4 vtr(lds_cptr p) { return __builtin_bit_cast(s16x4, __builtin_amdgcn_ds_read_tr16_b64_v4i16((__attribute__((address_space(3))) v4i16_t*)p)); }
#define ATT_WAIT_BAR() asm volatile("s_waitcnt vmcnt(0) lgkmcnt(0)\n\ts_barrier" ::: "memory")
__device__ __forceinline__ float min0f(float a) { float r; asm("v_min_f32_e32 %0, 0, %1" : "=v"(r) : "v"(a)); return r; }
__device__ __forceinline__ float max3f(float a, float b, float c) { float r; asm("v_max3_f32 %0, %1, %2, %3" : "=v"(r) : "v"(a), "v"(b), "v"(c)); return r; }
typedef float f32x2 __attribute__((ext_vector_type(2)));
__device__ __forceinline__ float swap_add(float v) { auto rr = __builtin_amdgcn_permlane32_swap(__float_as_uint(v), __float_as_uint(v), false, false); return __uint_as_float(rr[0]) + __uint_as_float(rr[1]); }
__device__ __forceinline__ float swap_max(float v) { auto rr = __builtin_amdgcn_permlane32_swap(__float_as_uint(v), __float_as_uint(v), false, false); return fmaxf(__uint_as_float(rr[0]), __uint_as_float(rr[1])); }

struct Tensors { const bf16* Q; const bf16* K; const bf16* V; bf16* O; };

template <int MODE, bool EARLY, int VAR = 0>
__device__ __forceinline__ void attn_unit(const Tensors& Tn, int b, int qcol, int kcol, int vcol, int ocol, int qb, float s2, float kmax, int upar, int wave_id, LAS char* shm, int rpass = -1, float lam = 0.f, const float* gsub = nullptr) {
    constexpr int DV = (MODE == 0) ? 128 : 64, NDB = DV / 32, NVP = NDB / 2;
    constexpr float THR = 8.0f;
    int tid_; asm volatile("v_mbcnt_lo_u32_b32 %0, -1, 0\n\tv_mbcnt_hi_u32_b32 %0, -1, %0\n\tv_lshl_add_u32 %0, %1, 6, %0" : "=&v"(tid_) : "s"(wave_id));
    const int tid = tid_, lane = tid & 63, r32 = lane & 31, hi = lane >> 5; const int wid = __builtin_amdgcn_readfirstlane(tid >> 6);
    const long rowbase = (long)b * SEQ; const int q0 = qb * 256;
    const bf16* Qw = Tn.Q + (rowbase + q0 + wid * 32) * PITCH + qcol;
    const bf16* Kh = Tn.K + rowbase * PITCH + kcol; const bf16* Vh = Tn.V + rowbase * PITCH + vcol;
    const unsigned lds0 = (unsigned)(uintptr_t)shm;
    LAS float* wsf = (LAS float*)(shm + L_WS) + wid * 64;
    volatile LAS unsigned* flags = (volatile LAS unsigned*)(shm + L_FLAG + (upar & 1) * 32);
    const lds_cptr shm3 = (lds_cptr)shm;
    const bf16* ksrc = Kh + (long)lane * PITCH + wid * 8;
    const unsigned kdst = lds0 + L_K + wid * 1024;
    const bf16* vsrc[NVP]; unsigned vdst[NVP];
#pragma unroll
    for (int i = 0; i < NVP; ++i) { const int p = wid + 8 * i; vsrc[i] = Vh + (long)(16 * (p & 3) + (lane >> 2)) * PITCH + (p >> 2) * 32 + (lane & 3) * 8; vdst[i] = lds0 + L_V + p * 1024; }
    const int NT = 4 * (qb + 1);
    bf16x8 qr[4];
#pragma unroll
    for (int d0 = 0; d0 < 4; ++d0) qr[d0] = *reinterpret_cast<const bf16x8*>(&Qw[(long)r32 * PITCH + d0 * 16 + hi * 8]);
    float ubqk = 0.f;
    if (MODE == 0 && EARLY) { float sq = 0.f;
#pragma unroll
        for (int d0 = 0; d0 < 4; ++d0)
#pragma unroll
            for (int k = 0; k < 8; ++k) { const float x = __uint_as_float(((unsigned)(unsigned short)qr[d0][k]) << 16); sq += x * x; }
        sq = swap_add(sq); ubqk = sqrtf(sq) * kmax * 1.01f + 0.25f; }
    f32x16 o[NDB];
#pragma unroll
    for (int d = 0; d < NDB; ++d) o[d] = f32x16{};
    float mref = 0.f, lsum = 0.f, R = 0.f; bool started = false, wdone = false;
    f32x16 bv = f32x16{};
    u32x4 akb0 = u32x4{}, akb1 = u32x4{}; unsigned s2w = 0u;
    if (MODE == 0) { const float off = (float)r32; const unsigned s2h = pk2(s2, 0.f) & 0xffffu; const float s2l = s2 - __uint_as_float(s2h << 16);
        if (hi == 0) { akb0.x = pk2(off, off); akb1.x = pk2(off + 32.0f, off + 32.0f); akb0.y = 0x3F803F80u; akb1.y = 0x3F803F80u; s2w = s2h | (pk2(s2l, 0.f) << 16); } }
    bf16x8 Mp0 = bf16x8{}, Mp1 = bf16x8{};
    if (MODE == 0) {
#pragma unroll
        for (int r = 0; r < 16; ++r) bv[r] = 0.f;
    } else {
#pragma unroll
        for (int j = 0; j < 8; ++j) { const int kvl = 4 * hi + (j & 3) + 8 * (j >> 2); Mp0[j] = (kvl > r32) ? (short)0x3F80 : (short)0; Mp1[j] = (16 + kvl > r32) ? (short)0x3F80 : (short)0; }
    }
    if (EARLY && wid == 0 && lane == 0) flags[0] = 0u;
#define ATT_ISSUE(jt_, slot_) do { glds16(ksrc + (long)(jt_) * 64 * PITCH, (unsigned)__builtin_amdgcn_readfirstlane(kdst + (slot_) * 8192)); \
        _Pragma("unroll") for (int i_ = 0; i_ < NVP; ++i_) glds16(vsrc[i_] + (long)(jt_) * 64 * PITCH, (unsigned)__builtin_amdgcn_readfirstlane(vdst[i_] + (slot_) * 16384)); } while (0)
    ATT_ISSUE(NT - 1, 0);
    ATT_WAIT_BAR();
    const int qlo = q0 + 32 * wid;
    for (int it = 0; it < NT; ++it) {
        const int jt = NT - 1 - it, cur = it & 1;
        if (it + 1 < NT) ATT_ISSUE(jt - 1, cur ^ 1);
        const bool active = (64 * jt <= qlo + 31) && !wdone;
        if (active) {
            const lds_cptr kp = shm3 + L_K + cur * 8192 + hi * 1024 + r32 * 16;
            const lds_cptr vp = shm3 + L_V + cur * 16384 + ((lane >> 4) & 1) * 32 + (lane & 3) * 8 + (4 * hi + ((lane & 15) >> 2)) * 64;
            const int qrel = qlo + r32 - 64 * jt;
            const bool band = (64 * jt + 63 >= qlo);
            f32x16 p0, p1;
            if (MODE == 0) {
                const float tb = s2 * (float)(64 * jt - q0);
                const float uu = tb - mref;
                const unsigned uh = pk2(uu, 0.f) & 0xffffu; const float ul = uu - __uint_as_float(uh << 16);
                u32x4 bq = u32x4{}; bq.x = s2w; bq.y = (hi == 0) ? (uh | (pk2(ul, 0.f) << 16)) : 0u;
                p0 = __builtin_amdgcn_mfma_f32_32x32x16_bf16(__builtin_bit_cast(bf16x8, akb0), __builtin_bit_cast(bf16x8, bq), f32x16{}, 0, 0, 0);
                p1 = __builtin_amdgcn_mfma_f32_32x32x16_bf16(__builtin_bit_cast(bf16x8, akb1), __builtin_bit_cast(bf16x8, bq), f32x16{}, 0, 0, 0);
            } else { p0 = f32x16{}; p1 = f32x16{}; }
#pragma unroll
            for (int d0 = 0; d0 < 4; ++d0) {
                const bf16x8 b0 = *(const __attribute__((address_space(3))) bf16x8*)(kp + d0 * 2048);
                const bf16x8 b1 = *(const __attribute__((address_space(3))) bf16x8*)(kp + d0 * 2048 + 512);
                p0 = __builtin_amdgcn_mfma_f32_32x32x16_bf16(b0, qr[d0], p0, 0, 0, 0);
                p1 = __builtin_amdgcn_mfma_f32_32x32x16_bf16(b1, qr[d0], p1, 0, 0, 0);
            }
            s16x4 vlo[NDB * 4], vhh[NDB * 4];
#pragma unroll
            for (int i = 0; i < 8; ++i) { vlo[i] = vtr(vp + (i >> 2) * 4096 + (i & 3) * 1024); vhh[i] = vtr(vp + (i >> 2) * 4096 + (i & 3) * 1024 + 512); }
            __builtin_amdgcn_sched_barrier(0);
            u32x4 pw0, pw1, pw2, pw3;
            if (MODE == 0) {
                if (band) {
#pragma unroll
                    for (int r = 0; r < 16; ++r) { const int kv = crow(r, hi); if (kv > qrel) p0[r] = -INFINITY; if (kv + 32 > qrel) p1[r] = -INFINITY; }
                }
                const bool need_ref = !started || !EARLY || __any(ubqk + s2 * (float)(64 * jt + 63 - q0) - mref > 40.0f);
                if (need_ref) {
                const float touch = __uint_as_float(((__float_as_uint(p0[15]) | __float_as_uint(p1[15])) & ((unsigned)upar >> 31)) | 0xff800000u);
                float rm = max3f(touch, p0[0], p1[0]), rm2 = max3f(touch, p0[1], p1[1]);
#pragma unroll
                for (int r = 2; r < 16; r += 2) { rm = max3f(rm, p0[r], p1[r]); rm2 = max3f(rm2, p0[r + 1], p1[r + 1]); }
                rm = max3f(rm, rm2, rm2);
                rm = swap_max(rm);
                if (!started) {
                    mref = rm;
#pragma unroll
                    for (int r = 0; r < 16; ++r) { p0[r] -= rm; p1[r] -= rm; }
                    started = true;
                } else if (__any(rm > THR)) {
                    const float dl = fmaxf(rm, 0.f); mref += dl;
#pragma unroll
                    for (int r = 0; r < 16; ++r) { p0[r] -= dl; p1[r] -= dl; }
                    const float f = __builtin_amdgcn_exp2f(-dl); lsum *= f;
                    if (hi == 0) wsf[r32] = f;
                    LDS_WAIT();
#pragma unroll
                    for (int r = 0; r < 16; ++r) { const float fr_ = wsf[crow(r, hi)];
#pragma unroll
                        for (int d = 0; d < NDB; ++d) o[d][r] *= fr_; }
                }
                }
#pragma unroll
                for (int r = 0; r < 16; ++r) { p0[r] = __builtin_amdgcn_exp2f(p0[r]); p1[r] = __builtin_amdgcn_exp2f(p1[r]); }
                f32x2 sa = (f32x2){p0[0], p0[1]} + (f32x2){p1[0], p1[1]}, sb = (f32x2){p0[2], p0[3]} + (f32x2){p1[2], p1[3]};
#pragma unroll
                for (int r = 4; r < 16; r += 4) { sa += (f32x2){p0[r], p0[r + 1]} + (f32x2){p1[r], p1[r + 1]}; sb += (f32x2){p0[r + 2], p0[r + 3]} + (f32x2){p1[r + 2], p1[r + 3]}; }
                sa += sb; lsum += sa.x + sa.y;
                if (EARLY) { if (__all(ubqk + s2 * (float)(64 * jt - 1 - q0) - mref < -40.0f)) { wdone = true; if (lane == 0) __hip_atomic_fetch_add((LAS unsigned*)&flags[0], 1u, __ATOMIC_RELAXED, __HIP_MEMORY_SCOPE_WORKGROUP); } }
            } else {
                f32x16 l0v, l1v; float rs0, rs1;
                {
                  f32x2 sa = (f32x2){0.f, 0.f}, sb = (f32x2){0.f, 0.f};
#pragma unroll
                  for (int r = 0; r < 16; r += 2) {
                    const f32x2 za = (f32x2){p0[r], p0[r + 1]}, zb = (f32x2){p1[r], p1[r + 1]};
                    f32x2 ea, eb; ea.x = __builtin_amdgcn_exp2f(-fabsf(za.x)); ea.y = __builtin_amdgcn_exp2f(-fabsf(za.y)); eb.x = __builtin_amdgcn_exp2f(-fabsf(zb.x)); eb.y = __builtin_amdgcn_exp2f(-fabsf(zb.y));
                    ea = ea + 1.0f; eb = eb + 1.0f;
                    f32x2 ga, gb; ga.x = __builtin_amdgcn_logf(ea.x); ga.y = __builtin_amdgcn_logf(ea.y); gb.x = __builtin_amdgcn_logf(eb.x); gb.y = __builtin_amdgcn_logf(eb.y);
                    f32x2 ma, mb; ma.x = 0.5f * (za.x - fabsf(za.x)); ma.y = 0.5f * (za.y - fabsf(za.y)); mb.x = 0.5f * (zb.x - fabsf(zb.x)); mb.y = 0.5f * (zb.y - fabsf(zb.y));
                    const f32x2 lba = ma - ga, lbb = mb - gb, la = lba - za, lb_ = lbb - zb;
                    p0[r] = lba.x; p0[r + 1] = lba.y; p1[r] = lbb.x; p1[r + 1] = lbb.y; l0v[r] = la.x; l0v[r + 1] = la.y; l1v[r] = lb_.x; l1v[r + 1] = lb_.y; }
                  if (band) {
#pragma unroll
                      for (int r = 0; r < 16; ++r) { if (!(crow(r, hi) < qrel)) { p0[r] = -INFINITY; l0v[r] = 0.f; } if (!(crow(r, hi) + 32 < qrel)) { p1[r] = -INFINITY; l1v[r] = 0.f; } } }
#pragma unroll
                  for (int r = 0; r < 16; r += 2) { sa += (f32x2){l0v[r], l0v[r + 1]}; sb += (f32x2){l1v[r], l1v[r + 1]}; }
                  rs0 = sa.x + sa.y; rs1 = sb.x + sb.y; }
                rs0 = swap_add(rs0); rs1 = swap_add(rs1);
                u32x4 h0, h1, h2, h3;
#define ATT_SPLIT(H, L, B) do { _Pragma("unroll") for (int k_ = 0; k_ < 4; ++k_) H[k_] = pk2(L[(B) + 2 * k_], L[(B) + 2 * k_ + 1]); } while (0)
                ATT_SPLIT(h0, l0v, 0); ATT_SPLIT(h1, l0v, 8); ATT_SPLIT(h2, l1v, 0); ATT_SPLIT(h3, l1v, 8);
#undef ATT_SPLIT
                f32x16 s0, s1;
                { const float c0 = R + rs1, c1 = R;
#pragma unroll
                  for (int r = 0; r < 16; ++r) { s0[r] = c0; s1[r] = c1; } }
#define ATT_BF(x) __builtin_bit_cast(bf16x8, x)
                s0 = __builtin_amdgcn_mfma_f32_32x32x16_bf16(Mp0, ATT_BF(h0), s0, 0, 0, 0); s1 = __builtin_amdgcn_mfma_f32_32x32x16_bf16(Mp0, ATT_BF(h2), s1, 0, 0, 0);
                s0 = __builtin_amdgcn_mfma_f32_32x32x16_bf16(Mp1, ATT_BF(h1), s0, 0, 0, 0); s1 = __builtin_amdgcn_mfma_f32_32x32x16_bf16(Mp1, ATT_BF(h3), s1, 0, 0, 0);
#pragma unroll
                for (int r = 0; r < 16; r += 2) { const f32x2 ta = (f32x2){p0[r], p0[r + 1]} + (f32x2){s0[r], s0[r + 1]}, tb = (f32x2){p1[r], p1[r + 1]} + (f32x2){s1[r], s1[r + 1]};
                    p0[r] = __builtin_amdgcn_exp2f(ta.x); p0[r + 1] = __builtin_amdgcn_exp2f(ta.y); p1[r] = __builtin_amdgcn_exp2f(tb.x); p1[r + 1] = __builtin_amdgcn_exp2f(tb.y); }
                R += rs0 + rs1;
                if (EARLY) { if (__all(R < -32.0f)) { wdone = true; if (lane == 0) __hip_atomic_fetch_add((LAS unsigned*)&flags[0], 1u, __ATOMIC_RELAXED, __HIP_MEMORY_SCOPE_WORKGROUP); } }
            }
            pw0 = (u32x4){pk2(p0[0], p0[1]), pk2(p0[2], p0[3]), pk2(p0[4], p0[5]), pk2(p0[6], p0[7])};
            pw1 = (u32x4){pk2(p0[8], p0[9]), pk2(p0[10], p0[11]), pk2(p0[12], p0[13]), pk2(p0[14], p0[15])};
            pw2 = (u32x4){pk2(p1[0], p1[1]), pk2(p1[2], p1[3]), pk2(p1[4], p1[5]), pk2(p1[6], p1[7])};
            pw3 = (u32x4){pk2(p1[8], p1[9]), pk2(p1[10], p1[11]), pk2(p1[12], p1[13]), pk2(p1[14], p1[15])};
            if (NDB == 4) {
                __builtin_amdgcn_sched_barrier(0);
#pragma unroll
                for (int i = 8; i < NDB * 4; ++i) { vlo[i] = vtr(vp + (i >> 2) * 4096 + (i & 3) * 1024); vhh[i] = vtr(vp + (i >> 2) * 4096 + (i & 3) * 1024 + 512); }
                __builtin_amdgcn_sched_barrier(0);
            }
#define ATT_PK(d_, k_) (bf16x8){vlo[(d_) * 4 + (k_)][0], vlo[(d_) * 4 + (k_)][1], vlo[(d_) * 4 + (k_)][2], vlo[(d_) * 4 + (k_)][3], vhh[(d_) * 4 + (k_)][0], vhh[(d_) * 4 + (k_)][1], vhh[(d_) * 4 + (k_)][2], vhh[(d_) * 4 + (k_)][3]}
#pragma unroll
            for (int dp = 0; dp < NDB; dp += 2) {
                o[dp] = __builtin_amdgcn_mfma_f32_32x32x16_bf16(ATT_BF(pw0), ATT_PK(dp, 0), o[dp], 0, 0, 0); o[dp + 1] = __builtin_amdgcn_mfma_f32_32x32x16_bf16(ATT_BF(pw0), ATT_PK(dp + 1, 0), o[dp + 1], 0, 0, 0);
                o[dp] = __builtin_amdgcn_mfma_f32_32x32x16_bf16(ATT_BF(pw1), ATT_PK(dp, 1), o[dp], 0, 0, 0); o[dp + 1] = __builtin_amdgcn_mfma_f32_32x32x16_bf16(ATT_BF(pw1), ATT_PK(dp + 1, 1), o[dp + 1], 0, 0, 0);
                o[dp] = __builtin_amdgcn_mfma_f32_32x32x16_bf16(ATT_BF(pw2), ATT_PK(dp, 2), o[dp], 0, 0, 0); o[dp + 1] = __builtin_amdgcn_mfma_f32_32x32x16_bf16(ATT_BF(pw2), ATT_PK(dp + 1, 2), o[dp + 1], 0, 0, 0);
                o[dp] = __builtin_amdgcn_mfma_f32_32x32x16_bf16(ATT_BF(pw3), ATT_PK(dp, 3), o[dp], 0, 0, 0); o[dp + 1] = __builtin_amdgcn_mfma_f32_32x32x16_bf16(ATT_BF(pw3), ATT_PK(dp + 1, 3), o[dp + 1], 0, 0, 0);
            }
#undef ATT_PK
        }
        ATT_WAIT_BAR();
        if (EARLY && wdone) { if (flags[0] == 8u) break; }
    }
#undef ATT_ISSUE
    float rli[16];
    if (MODE == 0) {
        lsum = swap_add(lsum);
        if (hi == 0) wsf[32 + r32] = lsum;
        LDS_WAIT();
#pragma unroll
        for (int r = 0; r < 16; ++r) rli[r] = __builtin_amdgcn_rcpf(wsf[32 + crow(r, hi)]);
    } else {
#pragma unroll
        for (int r = 0; r < 16; ++r) rli[r] = 1.0f;
    }
    bf16* Ow = Tn.O + (rowbase + q0 + wid * 32) * PITCH + ocol;
    { LAS bf16* stg = (LAS bf16*)(shm + L_OST) + wid * 4096;
      if (MODE == 0 && rpass == 1) {
          float gs[NDB];
#pragma unroll
          for (int d0 = 0; d0 < NDB; ++d0) gs[d0] = gsub[d0 * 32 + r32];
          float ssq[16];
#pragma unroll
          for (int r = 0; r < 16; ++r) { const int orow = crow(r, hi); float s = 0.f;
#pragma unroll
              for (int d0 = 0; d0 < NDB; ++d0) { const float o0 = __uint_as_float(((unsigned)stg[orow * DV + d0 * 32 + r32]) << 16); const float d = o0 - lam * (o[d0][r] * rli[r]); o[d0][r] = d; s += d * d; }
              ssq[r] = s; }
#pragma unroll
          for (int r = 0; r < 16; ++r) { const float s = half_sum32(ssq[r]);
              rli[r] = 1.0f / sqrtf(s * (1.0f / 128.0f) + 1e-6f); }
#pragma unroll
          for (int r = 0; r < 16; ++r)
#pragma unroll
              for (int d0 = 0; d0 < NDB; ++d0) o[d0][r] *= gs[d0];
          LDS_WAIT();
      }
#pragma unroll
      for (int r = 0; r < 16; ++r) { const int orow = crow(r, hi);
#pragma unroll
          for (int d0 = 0; d0 < NDB; ++d0) stg[orow * DV + d0 * 32 + r32] = (bf16)(pk2(o[d0][r] * rli[r], 0.f) & 0xffffu); }
      LDS_WAIT();
      if (!(MODE == 0 && rpass == 0)) {
      constexpr int CPR = DV / 8, RPI = 64 / CPR;
#pragma unroll
      for (int i = 0; i < 32 / RPI; ++i) { const int row = i * RPI + lane / CPR, ch = lane % CPR; const u32x4 v = *(const LAS u32x4*)(stg + row * DV + ch * 8); *(u32x4*)(Ow + (long)row * PITCH + ch * 8) = v; }
      LDS_WAIT(); } }
#undef ATT_BF
}
__device__ __forceinline__ bool unit_of(int vcu, int G, int i, int n_inst, int& inst, int& qb) {
    if (G == 256 && n_inst == 64) { if (i >= 8) return false; inst = vcu >> 2; const int pr = (vcu & 3) + 4 * (i >> 1); qb = (i & 1) ? 31 - pr : pr; return true; }
    const long L = (long)i * G + vcu; if (L >= (long)n_inst * 32) return false; inst = (int)(L >> 5); qb = (int)(L & 31); return true;
}
__device__ __forceinline__ bool unit_of_A(int vcu, int G, int i, int& b, int& head, int& r, int& qb) {
    if (G == 256) { if (i >= 8) return false; const int br = vcu >> 5, q = vcu & 31, q2 = (q + 16) & 31, brh = (br + i) & 7; head = i; b = brh >> 1; r = brh & 1;
        qb = ((i & 3) == 0) ? q : ((i & 3) == 1) ? 31 - q : ((i & 3) == 2) ? q2 : 31 - q2; return true; }
    int inst; if (!unit_of(vcu, G, i, 64, inst, qb)) return false; b = inst >> 4; head = (inst >> 1) & 7; r = inst & 1; return true;
}
__device__ __forceinline__ void unit_of_Aq(int qx, int idx, int& b, int& head, int& qb) { const int i = idx >> 5; qb = 31 - (idx & 31); b = qx >> 1;
    head = (qx & 1) ? ((i == 0) ? 6 : (i == 1) ? 4 : (i == 2) ? 3 : 2) : ((i == 0) ? 7 : (i == 1) ? 5 : (i == 2) ? 1 : 0); }
}


struct Frame {
    LAS unsigned char* lds;
    volatile LAS unsigned* MISC;
    gu32* ctl;
    int tid, lane, wave, vcu, G;
    unsigned char* ws;
};
__device__ __forceinline__ const float* inptr(const Frame& F, int i) { const unsigned lo = __builtin_amdgcn_readfirstlane(F.MISC[176 + 2 * i]), hi = __builtin_amdgcn_readfirstlane(F.MISC[177 + 2 * i]); return (const float*)(const GAS float*)(((unsigned long long)hi << 32) | lo); }
#define FIN(i) inptr(F, (i))
#define FOUT ((float*)inptr(F, 23))
enum { I_X = 0, I_C, I_ADAW, I_ADAB, I_NMIX, I_NMOE, I_AWQKV, I_AWO, I_ALAM, I_ASUBLN, I_KVNORM, I_KVADAW, I_KVADAB, I_KVW, I_BWQ, I_BWO, I_RW, I_RB, I_WGU, I_BGU, I_WD, I_BD, I_FNORM };
#define WSP(T_, off) ((T_*)(GAS T_*)(F.ws + (off)))

__device__ __forceinline__ void transpose_item(const float* W, int ldw, int k0, int n0, bf16* WT, int K, int drow0, LAS float* scr, int lane) {
    { const GAS float* wg = (const GAS float*)W + (size_t)k0 * ldw + n0 + (lane & 31) + (size_t)(lane >> 5) * ldw; float v[32];
#pragma unroll
      for (int i = 0; i < 32; ++i) v[i] = wg[(size_t)(2 * i) * ldw];
#pragma unroll
      for (int i = 0; i < 32; ++i) scr[(2 * i + (lane >> 5)) * 33 + (lane & 31)] = v[i]; }
    LDS_WAIT(); asm volatile("" ::: "memory");
    const int c = lane & 7;
#pragma unroll
    for (int j = 0; j < 4; ++j) { const int n = (lane >> 3) + 8 * j; const LAS float* s = scr + (8 * c) * 33 + n;
        v4u o; o.x = pk2(s[0 * 33], s[1 * 33]); o.y = pk2(s[2 * 33], s[3 * 33]); o.z = pk2(s[4 * 33], s[5 * 33]); o.w = pk2(s[6 * 33], s[7 * 33]);
        *(GAS v4u*)(WT + (size_t)(drow0 + n) * K + k0 + 8 * c) = o; }
    LDS_WAIT(); asm volatile("" ::: "memory");
}
__device__ __forceinline__ void transpose_item8(const float* W, int ldw, int k0, int n0, unsigned char* WT, int K, int drow0, LAS float* scr, int lane) {
    LAS unsigned* t = (LAS unsigned*)scr;
    const int kr = lane >> 4, nq = lane & 15;
    const GAS float* wp = (const GAS float*)W + (size_t)(k0 + 4 * kr) * ldw + n0 + 4 * nq;
    f32x4 v[8][4];
#pragma unroll
    for (int i = 0; i < 8; ++i)
#pragma unroll
        for (int j = 0; j < 4; ++j) v[i][j] = __builtin_nontemporal_load((const GAS f32x4*)(wp + (size_t)(16 * i + j) * ldw));
#pragma unroll
    for (int i = 0; i < 8; ++i)
#pragma unroll
        for (int c = 0; c < 4; ++c) t[(4 * nq + c) * 33 + 4 * i + kr] = pk4f8(v[i][0][c] * 256.0f, v[i][1][c] * 256.0f, v[i][2][c] * 256.0f, v[i][3][c] * 256.0f);
    LDS_WAIT(); asm volatile("" ::: "memory");
    const int c8 = lane & 7;
#pragma unroll
    for (int j = 0; j < 8; ++j) { const int n = (lane >> 3) + 8 * j; const LAS unsigned* s = t + n * 33 + 4 * c8;
        v4u o; o.x = s[0]; o.y = s[1]; o.z = s[2]; o.w = s[3];
        __builtin_nontemporal_store(o, (GAS v4u*)(WT + (size_t)(drow0 + n) * K + k0 + 16 * c8)); }
    LDS_WAIT(); asm volatile("" ::: "memory");
}
__device__ __forceinline__ void mod_item(const float* c, const float* W, int ldw, int n0, int s, float* out, int ldo, LAS float* scr, int lane) {
#pragma unroll
    for (int i = 0; i < 8; ++i) { const int idx = i * 64 + lane, b = idx >> 7, kk = idx & 127; const float v = c[b * 1024 + s * 128 + kk]; scr[idx] = v * __builtin_amdgcn_rcpf(1.0f + __builtin_amdgcn_exp2f(-v * LOG2E)); }
    LDS_WAIT(); asm volatile("" ::: "memory");
    float a0 = 0.f, a1 = 0.f, a2 = 0.f, a3 = 0.f;
    const GAS float* wp = (const GAS float*)W + (size_t)(s * 128) * ldw + n0 + lane;
    { float w[128];
#pragma unroll
      for (int k = 0; k < 128; ++k) w[k] = wp[(size_t)k * ldw];
#pragma unroll
      for (int k = 0; k < 128; k += 4) { const f32x4 c0 = *(const LAS f32x4*)(scr + k), c1 = *(const LAS f32x4*)(scr + 128 + k), c2 = *(const LAS f32x4*)(scr + 256 + k), c3 = *(const LAS f32x4*)(scr + 384 + k);
          a0 += (c0.x * w[k] + c0.y * w[k + 1]) + (c0.z * w[k + 2] + c0.w * w[k + 3]); a1 += (c1.x * w[k] + c1.y * w[k + 1]) + (c1.z * w[k + 2] + c1.w * w[k + 3]);
          a2 += (c2.x * w[k] + c2.y * w[k + 1]) + (c2.z * w[k + 2] + c2.w * w[k + 3]); a3 += (c3.x * w[k] + c3.y * w[k + 1]) + (c3.z * w[k + 2] + c3.w * w[k + 3]); } }
    out[0 * ldo + n0 + lane] = a0; out[1 * ldo + n0 + lane] = a1; out[2 * ldo + n0 + lane] = a2; out[3 * ldo + n0 + lane] = a3;
    LDS_WAIT(); asm volatile("" ::: "memory");
}
__device__ __forceinline__ void mod_reduce_pass(Frame& F) {
    const float* mp = WSP(const float, WS_MODP); float* mod = WSP(float, WS_MOD);
    for (int i = (int)blockIdx.x * (NWAVES * 64) + F.tid; i < MODN; i += F.G * NWAVES * 64) {
        float s = (i < DEPTH * BATCH * 6 * D) ? FIN(I_ADAB)[(size_t)(i / (BATCH * 6 * D)) * 6 * D + i % (6 * D)] : FIN(I_KVADAB)[(i - DEPTH * BATCH * 6 * D) % (2 * D)];
#pragma unroll
        for (int p = 0; p < MODS; ++p) s += mp[(size_t)p * MODN + i];
        mod[i] = s; }
}
__device__ __forceinline__ void expert_item(Frame& F, int lay, int r, LAS float* scr) {
    if (r < NE * 256) { const int le = lay * NE + r / 256, q = r % 256, kb = q / 32, nb = q % 32;
        const int n0 = nb * 64, isu = n0 >> 10, jb = n0 & 1023, drow = (jb >> 7) * 256 + isu * 128 + (jb & 127);
        transpose_item8(FIN(I_WGU) + (size_t)le * D * 2 * D, 2 * D, kb * 128, n0, WSP(unsigned char, WS_WGU) + (size_t)le * 2 * D * D, D, drow, scr, F.lane); }
    else { r -= NE * 256; const int le = lay * NE + r / 128, q = r % 128, kb = q / 16, nb = q % 16;
        transpose_item8(FIN(I_WD) + (size_t)le * D * D, D, kb * 128, nb * 64, WSP(unsigned char, WS_WD) + (size_t)le * D * D, D, nb * 64, scr, F.lane); }
}
__device__ __forceinline__ void expert_conv_unit(Frame& F, int lp, int cu) {
    LAS float* scr = (LAS float*)(F.lds + RING_OFF + F.wave * 16384);
#pragma unroll 1
    for (int t = 0; t < 4; ++t) { const int j = cu * 32 + F.wave + 8 * t; expert_item(F, 2 * lp + j / (NE * 384), j % (NE * 384), scr); }
}
__device__ __forceinline__ void p0_prologue(Frame& F) {
    LAS float* scr = (LAS float*)(F.lds + RING_OFF + F.wave * 16384);
    constexpr int I_MOD = (DEPTH * 96 + 32) * MODS;
    constexpr int IT_QKV = 2 * 16 * 96, IT_SQ = 2 * 16 * 32, IT_KV = 16 * 64;
    constexpr int NITEMS = I_MOD + IT_QKV + IT_SQ   + IT_KV + IT_SQ   + IT_SQ  ;
    const int gw = F.vcu * NWAVES + F.wave, NGW = F.G * NWAVES;
    for (int it = gw; it < NITEMS; it += NGW) {
        int r = it;
        if (r < I_MOD) { const int s = r % MODS, cch = r / MODS; float* pl = WSP(float, WS_MODP) + (size_t)s * MODN;
            if (cch < DEPTH * 96) { const int l = cch / 96, nb = cch % 96; mod_item(FIN(I_C), FIN(I_ADAW) + (size_t)l * D * 6 * D, 6 * D, nb * 64, s, pl + (size_t)l * BATCH * 6 * D, 6 * D, scr, F.lane); }
            else { const int nb = cch - DEPTH * 96; mod_item(FIN(I_C), FIN(I_KVADAW), 2 * D, nb * 64, s, pl + (size_t)DEPTH * BATCH * 6 * D, 2 * D, scr, F.lane); }
            continue; }
        r -= I_MOD;
        if (r < IT_QKV) { const int l = r / (16 * 96), q = r % (16 * 96), kb = q / 96, nb = q % 96;
            transpose_item(FIN(I_AWQKV) + (size_t)l * D * 3 * D, 3 * D, kb * 64, nb * 32, WSP(bf16, WS_WQKV) + (size_t)l * 3 * D * D, D, nb * 32, scr, F.lane); continue; }
        r -= IT_QKV;
        if (r < IT_SQ) { const int l = r / 512, q = r % 512, kb = q / 32, nb = q % 32;
            transpose_item(FIN(I_AWO) + (size_t)l * D * D, D, kb * 64, nb * 32, WSP(bf16, WS_WOA) + (size_t)l * D * D, D, nb * 32, scr, F.lane); continue; }
        r -= IT_SQ;
        if (r < IT_KV) { const int kb = r / 64, nb = r % 64;
            transpose_item(FIN(I_KVW), 2 * D, kb * 64, nb * 32, WSP(bf16, WS_WKV), D, nb * 32, scr, F.lane); continue; }
        r -= IT_KV;
        if (r < IT_SQ) { const int l = r / 512, q = r % 512, kb = q / 32, nb = q % 32;
            transpose_item(FIN(I_BWQ) + (size_t)l * D * D, D, kb * 64, nb * 32, WSP(bf16, WS_WQB) + (size_t)l * D * D, D, nb * 32, scr, F.lane); continue; }
        r -= IT_SQ;
        { const int l = r / 512, q = r % 512, kb = q / 32, nb = q % 32;
            transpose_item(FIN(I_BWO) + (size_t)l * D * D, D, kb * 64, nb * 32, WSP(bf16, WS_WOB) + (size_t)l * D * D, D, nb * 32, scr, F.lane); }
    }
}

__device__ __forceinline__ void norm_combine_pass(Frame& F, int l, bool dry = false) {
    int gw = F.vcu * NWAVES + F.wave; asm volatile("" : "+s"(gw));
    const int NGW = F.G * NWAVES;
    const int RPW = (T + NGW - 1) / NGW;
    const float* xin32 = FIN(I_X);
    bf16* xcur = WSP(bf16, WS_XCUR);
    const unsigned char* YS = WSP(const unsigned char, WS_YS); const int* slot_row = WSP(const int, WS_SLOT_ROW);
    const float* mod = WSP(const float, WS_MOD); const float* kvmod = WSP(const float, WS_KVMOD);
    const int m0 = gw * RPW; if (m0 >= T) return;
    const int mend = (m0 + RPW < T) ? m0 + RPW : T;
    const int b = m0 >> 13;
    f32x4 g2v[4], gnv[4], shv[4], scv[4];
#pragma unroll
    for (int j = 0; j < 4; ++j) { const int c0 = 4 * F.lane + 256 * j;
        g2v[j] = (l > 0) ? *(const GAS f32x4*)(mod + ((size_t)(l - 1) * BATCH + b) * 6 * D + 5 * D + c0) * (1.0f / 16.0f) : (f32x4){0.f, 0.f, 0.f, 0.f};
        if (l == DEPTH) { gnv[j] = *(const GAS f32x4*)(FIN(I_FNORM) + c0); shv[j] = (f32x4){0.f, 0.f, 0.f, 0.f}; scv[j] = (f32x4){0.f, 0.f, 0.f, 0.f}; }
        else { const float* md = mod + ((size_t)l * BATCH + b) * 6 * D; gnv[j] = *(const GAS f32x4*)(FIN(I_NMIX) + (size_t)l * D + c0); shv[j] = *(const GAS f32x4*)(md + c0); scv[j] = *(const GAS f32x4*)(md + D + c0) + 1.0f; } }
    int srl = 0;
    if (l > 0 && F.lane < (mend - m0) * 4) srl = slot_row[(size_t)m0 * 4 + F.lane];
    for (int mb = m0; mb < mend; mb += 2) {
        f32x4 v[2][4]; unsigned ys[2][4][4];
#pragma unroll
        for (int q = 0; q < 2; ++q) { const int m = (mb + q < mend) ? mb + q : mb;
#pragma unroll
            for (int j = 0; j < 4; ++j) {
                if (l == 0) v[q][j] = __builtin_nontemporal_load((const GAS f32x4*)(xin32 + (size_t)m * D + 4 * F.lane + 256 * j));
                else { const v2u r = __builtin_nontemporal_load((const GAS v2u*)(xcur + (size_t)m * D + 4 * F.lane + 256 * j)); v[q][j] = (f32x4){bflo(r.x), bfhi(r.x), bflo(r.y), bfhi(r.y)}; } }
            if (l > 0) {
#pragma unroll
                for (int s = 0; s < 4; ++s) { const int rw = (RPW <= 16) ? __builtin_amdgcn_readlane(srl, ((m - m0) * 4 + s) & 63) : __builtin_amdgcn_readfirstlane(slot_row[(size_t)m * 4 + s]);
#pragma unroll
                    for (int j = 0; j < 4; ++j) ys[q][s][j] = __builtin_nontemporal_load((const GAS unsigned*)(YS + (size_t)rw * D + 4 * F.lane + 256 * j)); } } }
#pragma unroll
        for (int q = 0; q < 2; ++q) { const int m = mb + q; if (m >= mend) break;
            if (l > 0) {
#pragma unroll
                for (int j = 0; j < 4; ++j) { f32x4 acc = (f32x4){0.f, 0.f, 0.f, 0.f};
#pragma unroll
                    for (int s = 0; s < 4; ++s) acc += f8x4_to_f32(ys[q][s][j]);
                    v[q][j] += g2v[j] * acc; }
                if (l < DEPTH && !dry) {
#pragma unroll
                    for (int j = 0; j < 4; ++j) { v2u w; w.x = pk2(v[q][j].x, v[q][j].y); w.y = pk2(v[q][j].z, v[q][j].w); __builtin_nontemporal_store(w, (GAS v2u*)(xcur + (size_t)m * D + 4 * F.lane + 256 * j)); }
                }
            }
            float ss = 0.f;
#pragma unroll
            for (int j = 0; j < 4; ++j) ss += (v[q][j].x * v[q][j].x + v[q][j].y * v[q][j].y) + (v[q][j].z * v[q][j].z + v[q][j].w * v[q][j].w);
            const float rstd = 1.0f / sqrtf(wave_sum(ss) * (1.0f / D) + EPS);
            if (l == DEPTH) {
#pragma unroll
                for (int j = 0; j < 4; ++j) __builtin_nontemporal_store(v[q][j] * rstd * gnv[j], (GAS f32x4*)(FOUT + (size_t)m * D + 4 * F.lane + 256 * j));
            } else {
#pragma unroll
                for (int j = 0; j < 4; ++j) { const int c0 = 4 * F.lane + 256 * j; const f32x4 h = (v[q][j] * rstd * gnv[j]) * scv[j] + shv[j];
                    v2u w; w.x = pk2(h.x, h.y); w.y = pk2(h.z, h.w); *(GAS v2u*)(WSP(bf16, WS_H) + (size_t)m * D + c0) = w; }
                if (l == 2) {
                    const float* kd = kvmod + (size_t)b * 2 * D;
#pragma unroll
                    for (int j = 0; j < 4; ++j) { const int c0 = 4 * F.lane + 256 * j;
                        const f32x4 gn = *(const GAS f32x4*)(FIN(I_KVNORM) + c0), sh = *(const GAS f32x4*)(kd + c0), sc = *(const GAS f32x4*)(kd + D + c0);
                        const f32x4 h = (v[q][j] * rstd * gn) * (sc + 1.0f) + sh;
                        v2u w; w.x = pk2(h.x, h.y); w.y = pk2(h.z, h.w); *(GAS v2u*)(WSP(bf16, WS_HKV) + (size_t)m * D + c0) = w; }
                }
            }
        }
    }
}

__device__ __forceinline__ void norm_combine_pass8(Frame& F, int l, bool dry = false) {
    int gw = F.vcu * NWAVES + F.wave; asm volatile("" : "+s"(gw));
    const int NGW = F.G * NWAVES;
    const int RPW = (T + NGW - 1) / NGW;
    bf16* xcur = WSP(bf16, WS_XCUR);
    const unsigned char* YS = WSP(const unsigned char, WS_YS); const int* slot_row = WSP(const int, WS_SLOT_ROW);
    const float* mod = WSP(const float, WS_MOD); const float* kvmod = WSP(const float, WS_KVMOD);
    const int m0 = gw * RPW; if (m0 >= T) return;
    const int mend = (m0 + RPW < T) ? m0 + RPW : T;
    const int b = m0 >> 13;
    const int cl = 8 * F.lane;
    f32x4 g2v[4], gnv[4], shv[4], scv[4];
#pragma unroll
    for (int jh = 0; jh < 4; ++jh) { const int c0 = cl + 512 * (jh >> 1) + 4 * (jh & 1);
        g2v[jh] = *(const GAS f32x4*)(mod + ((size_t)(l - 1) * BATCH + b) * 6 * D + 5 * D + c0) * (1.0f / 4.0f);
        if (l == DEPTH) { gnv[jh] = *(const GAS f32x4*)(FIN(I_FNORM) + c0); shv[jh] = (f32x4){0.f, 0.f, 0.f, 0.f}; scv[jh] = (f32x4){0.f, 0.f, 0.f, 0.f}; }
        else { const float* md = mod + ((size_t)l * BATCH + b) * 6 * D; gnv[jh] = *(const GAS f32x4*)(FIN(I_NMIX) + (size_t)l * D + c0); shv[jh] = *(const GAS f32x4*)(md + c0); scv[jh] = *(const GAS f32x4*)(md + D + c0) + 1.0f; } }
    int srl = 0;
    if (F.lane < (mend - m0) * 4) srl = slot_row[(size_t)m0 * 4 + F.lane];
    const float* slot_gate = WSP(const float, WS_SLOT_GATE); float sgl = 0.f;
    if (F.lane < (mend - m0) * 4) sgl = slot_gate[(size_t)m0 * 4 + F.lane];
    for (int mb = m0; mb < mend; mb += 4) {
        v4u xr[4][2]; v2u ys[4][4][2]; float gs[4][4];
#pragma unroll
        for (int q = 0; q < 4; ++q) { const int m = (mb + q < mend) ? mb + q : mb;
#pragma unroll
            for (int j = 0; j < 2; ++j) xr[q][j] = __builtin_nontemporal_load((const GAS v4u*)(xcur + (size_t)m * D + cl + 512 * j));
#pragma unroll
            for (int s = 0; s < 4; ++s) { const int rw = (RPW <= 16) ? __builtin_amdgcn_readlane(srl, ((m - m0) * 4 + s) & 63) : __builtin_amdgcn_readfirstlane(slot_row[(size_t)m * 4 + s]);
                gs[q][s] = (RPW <= 16) ? __int_as_float(__builtin_amdgcn_readlane(__float_as_int(sgl), ((m - m0) * 4 + s) & 63)) : __int_as_float(__builtin_amdgcn_readfirstlane(__float_as_int(slot_gate[(size_t)m * 4 + s])));
#pragma unroll
                for (int j = 0; j < 2; ++j) ys[q][s][j] = __builtin_nontemporal_load((const GAS v2u*)(YS + (size_t)rw * D + cl + 512 * j)); } }
#pragma unroll
        for (int q = 0; q < 4; ++q) { const int m = mb + q; if (m >= mend) break;
            f32x4 v[4];
#pragma unroll
            for (int jh = 0; jh < 4; ++jh) { const int j = jh >> 1, h = jh & 1; const unsigned w0 = xr[q][j][2 * h], w1 = xr[q][j][2 * h + 1];
                f32x4 acc = f8x4_to_f32(ys[q][0][j][h]) * gs[q][0];
#pragma unroll
                for (int s = 1; s < 4; ++s) acc += f8x4_to_f32(ys[q][s][j][h]) * gs[q][s];
                v[jh] = (f32x4){bflo(w0), bfhi(w0), bflo(w1), bfhi(w1)} + g2v[jh] * acc; }
            if (l < DEPTH && !dry) {
#pragma unroll
                for (int j = 0; j < 2; ++j) { v4u w; w.x = pk2(v[2 * j].x, v[2 * j].y); w.y = pk2(v[2 * j].z, v[2 * j].w); w.z = pk2(v[2 * j + 1].x, v[2 * j + 1].y); w.w = pk2(v[2 * j + 1].z, v[2 * j + 1].w);
                    __builtin_nontemporal_store(w, (GAS v4u*)(xcur + (size_t)m * D + cl + 512 * j)); }
            }
            float ss = 0.f;
#pragma unroll
            for (int jh = 0; jh < 4; ++jh) ss += (v[jh].x * v[jh].x + v[jh].y * v[jh].y) + (v[jh].z * v[jh].z + v[jh].w * v[jh].w);
            const float rstd = 1.0f / sqrtf(wave_sum(ss) * (1.0f / D) + EPS);
            if (l == DEPTH) {
#pragma unroll
                for (int jh = 0; jh < 4; ++jh) __builtin_nontemporal_store(v[jh] * rstd * gnv[jh], (GAS f32x4*)(FOUT + (size_t)m * D + cl + 512 * (jh >> 1) + 4 * (jh & 1)));
            } else {
#pragma unroll
                for (int j = 0; j < 2; ++j) { const f32x4 h0 = (v[2 * j] * rstd * gnv[2 * j]) * scv[2 * j] + shv[2 * j], h1 = (v[2 * j + 1] * rstd * gnv[2 * j + 1]) * scv[2 * j + 1] + shv[2 * j + 1];
                    v4u w; w.x = pk2(h0.x, h0.y); w.y = pk2(h0.z, h0.w); w.z = pk2(h1.x, h1.y); w.w = pk2(h1.z, h1.w); *(GAS v4u*)(WSP(bf16, WS_H) + (size_t)m * D + cl + 512 * j) = w; }
                if (l == 2) {
                    const float* kd = kvmod + (size_t)b * 2 * D;
#pragma unroll
                    for (int j = 0; j < 2; ++j) { f32x4 hh[2];
#pragma unroll
                        for (int h = 0; h < 2; ++h) { const int c0 = cl + 512 * j + 4 * h;
                            const f32x4 gn = *(const GAS f32x4*)(FIN(I_KVNORM) + c0), sh = *(const GAS f32x4*)(kd + c0), sc = *(const GAS f32x4*)(kd + D + c0);
                            hh[h] = (v[2 * j + h] * rstd * gn) * (sc + 1.0f) + sh; }
                        v4u w; w.x = pk2(hh[0].x, hh[0].y); w.y = pk2(hh[0].z, hh[0].w); w.z = pk2(hh[1].x, hh[1].y); w.w = pk2(hh[1].z, hh[1].w); *(GAS v4u*)(WSP(bf16, WS_HKV) + (size_t)m * D + cl + 512 * j) = w; }
                }
            }
        }
    }
}

__device__ __forceinline__ void diff_combine_pass(Frame& F, int l) {
    const int gw = F.vcu * NWAVES + F.wave, NGW = F.G * NWAVES;
    const float lam_init = (l == 0) ? 0.2f : (0.8f - 0.6f * 0.74081822068171788f);
    const float* lv = FIN(I_ALAM) + (size_t)l * 256;
    const float s01 = wave_sum(lv[F.lane] * lv[64 + F.lane]), s23 = wave_sum(lv[128 + F.lane] * lv[192 + F.lane]);
    const float lam = expf(s01) - expf(s23) + lam_init;
    const float* sg = FIN(I_ASUBLN) + (size_t)l * 128 + (16 * F.lane) % 128;
    float gsub[16];
#pragma unroll
    for (int i = 0; i < 16; ++i) gsub[i] = sg[i] * (1.0f - lam_init);
    const bf16* O0 = WSP(const bf16, WS_O0); const bf16* O1 = WSP(const bf16, WS_O1); bf16* OC = WSP(bf16, WS_OC);
    for (int m = gw; m < T; m += NGW) {
        const size_t off = (size_t)m * D + 16 * F.lane;
        const v4u a0 = *(const GAS v4u*)(O0 + off), a1 = *(const GAS v4u*)(O0 + off + 8), b0 = *(const GAS v4u*)(O1 + off), b1 = *(const GAS v4u*)(O1 + off + 8);
        float d[16];
#pragma unroll
        for (int k = 0; k < 4; ++k) { d[2 * k] = bflo(a0[k]) - lam * bflo(b0[k]); d[2 * k + 1] = bfhi(a0[k]) - lam * bfhi(b0[k]); d[8 + 2 * k] = bflo(a1[k]) - lam * bflo(b1[k]); d[8 + 2 * k + 1] = bfhi(a1[k]) - lam * bfhi(b1[k]); }
        float ss = 0.f;
#pragma unroll
        for (int i = 0; i < 16; ++i) ss += d[i] * d[i];
        ss += __shfl_xor(ss, 1); ss += __shfl_xor(ss, 2); ss += __shfl_xor(ss, 4);
        const float rstd = 1.0f / sqrtf(ss * (1.0f / 128.0f) + EPS);
        v4u w0, w1;
#pragma unroll
        for (int k = 0; k < 4; ++k) { w0[k] = pk2(d[2 * k] * rstd * gsub[2 * k], d[2 * k + 1] * rstd * gsub[2 * k + 1]); w1[k] = pk2(d[8 + 2 * k] * rstd * gsub[8 + 2 * k], d[8 + 2 * k + 1] * rstd * gsub[8 + 2 * k + 1]); }
        *(GAS v4u*)(OC + off) = w0; *(GAS v4u*)(OC + off + 8) = w1;
    }
}

__device__ __forceinline__ void router_pass(Frame& F, int l, bool dry = false) {
    constexpr int HS_LD = 1028;
    LAS float* hs = (LAS float*)(F.lds + RING_OFF); LAS float* red = (LAS float*)(F.lds + RING_OFF + 69632);
    LAS int* tabE = (LAS int*)(F.lds + TAB_OFF); LAS int* tabP = tabE + 1024; LAS float* tabG = (LAS float*)(tabP + 1024);
    volatile LAS unsigned* lcnt = F.MISC + 80; volatile LAS unsigned* gbase = F.MISC + 120;
    const bf16* xcur = WSP(const bf16, WS_XCUR); const float* mod = WSP(const float, WS_MOD);
    const float* rwt = FIN(I_RW) + (size_t)l * D * NE; const float* rbs = FIN(I_RB) + (size_t)l * NE;
    const int NGRP = T / 16, gpb = (NGRP + F.G - 1) / F.G;
    const int g0 = (int)blockIdx.x * gpb; const int gn_ = (g0 + gpb <= NGRP) ? gpb : (NGRP > g0 ? NGRP - g0 : 0);
    if (F.tid < NE) lcnt[F.tid] = 0u;
    const int e = F.lane & 31, kh = F.lane >> 5, kb = 128 * F.wave;
    const int fn = F.lane & 15, fq = F.lane >> 4;
    v4u wh[4][2], wl[4][2];
#pragma unroll
    for (int s = 0; s < 4; ++s)
#pragma unroll
        for (int nh = 0; nh < 2; ++nh) { float w8[8];
#pragma unroll
            for (int i = 0; i < 8; ++i) w8[i] = rwt[(size_t)(kb + 32 * s + 8 * fq + i) * NE + 16 * nh + fn];
#pragma unroll
            for (int i = 0; i < 4; ++i) { const unsigned h = pk2(w8[2 * i], w8[2 * i + 1]); wh[s][nh][i] = h; wl[s][nh][i] = pk2(w8[2 * i] - bflo(h), w8[2 * i + 1] - bfhi(h)); } }
    const float rbe = rbs[e];
    const int b = (g0 * 16) >> 13;
    f32x4 gnv[4], shv[4], scv[4];
    { const float* md = mod + ((size_t)l * BATCH + b) * 6 * D;
#pragma unroll
      for (int j = 0; j < 4; ++j) { const int c0 = 4 * F.lane + 256 * j; gnv[j] = *(const GAS f32x4*)(FIN(I_NMOE) + (size_t)l * D + c0); shv[j] = *(const GAS f32x4*)(md + 3 * D + c0); scv[j] = *(const GAS f32x4*)(md + 4 * D + c0) + 1.0f; } }
    v2u xr[2][4];
    if (gn_ > 0) {
#pragma unroll
        for (int rr = 0; rr < 2; ++rr)
#pragma unroll
            for (int j = 0; j < 4; ++j) xr[rr][j] = __builtin_nontemporal_load((const GAS v2u*)(xcur + (size_t)(g0 * 16 + 2 * F.wave + rr) * D + 4 * F.lane + 256 * j));
    }
    __syncthreads();
    for (int gi = 0; gi < gn_; ++gi) {
        const int m0 = (g0 + gi) * 16;
#pragma unroll
        for (int rr = 0; rr < 2; ++rr) { const int r = 2 * F.wave + rr, m = m0 + r; float ss = 0.f; f32x4 xv[4];
#pragma unroll
            for (int j = 0; j < 4; ++j) { xv[j] = (f32x4){bflo(xr[rr][j].x), bfhi(xr[rr][j].x), bflo(xr[rr][j].y), bfhi(xr[rr][j].y)}; ss += (xv[j].x * xv[j].x + xv[j].y * xv[j].y) + (xv[j].z * xv[j].z + xv[j].w * xv[j].w); }
            const float rstd = 1.0f / sqrtf(wave_sum(ss) * (1.0f / D) + EPS);
#pragma unroll
            for (int j = 0; j < 4; ++j) { const int c0 = 4 * F.lane + 256 * j; const f32x4 h = (xv[j] * rstd * gnv[j]) * scv[j] + shv[j];
                *(LAS f32x4*)(hs + r * HS_LD + c0) = h;
                *(GAS unsigned*)(WSP(unsigned char, WS_H) + (size_t)m * D + c0) = pk4f8(h.x, h.y, h.z, h.w); } }
        if (gi + 1 < gn_) {
#pragma unroll
            for (int rr = 0; rr < 2; ++rr)
#pragma unroll
                for (int j = 0; j < 4; ++j) xr[rr][j] = __builtin_nontemporal_load((const GAS v2u*)(xcur + (size_t)(m0 + 16 + 2 * F.wave + rr) * D + 4 * F.lane + 256 * j));
        }
        __syncthreads();
        { f32x4 accL[2] = {(f32x4){0.f, 0.f, 0.f, 0.f}, (f32x4){0.f, 0.f, 0.f, 0.f}};
#pragma unroll
          for (int s = 0; s < 4; ++s) { const LAS float* hp = hs + fn * HS_LD + kb + 32 * s + 8 * fq; const f32x4 a0 = *(const LAS f32x4*)hp, a1 = *(const LAS f32x4*)(hp + 4);
              v4u ah, al;
              ah.x = pk2(a0.x, a0.y); ah.y = pk2(a0.z, a0.w); ah.z = pk2(a1.x, a1.y); ah.w = pk2(a1.z, a1.w);
              al.x = pk2(a0.x - bflo(ah.x), a0.y - bfhi(ah.x)); al.y = pk2(a0.z - bflo(ah.y), a0.w - bfhi(ah.y)); al.z = pk2(a1.x - bflo(ah.z), a1.y - bfhi(ah.z)); al.w = pk2(a1.z - bflo(ah.w), a1.w - bfhi(ah.w));
#pragma unroll
              for (int nh = 0; nh < 2; ++nh) {
                  accL[nh] = __builtin_amdgcn_mfma_f32_16x16x32_bf16(__builtin_bit_cast(bf16x8, ah), __builtin_bit_cast(bf16x8, wh[s][nh]), accL[nh], 0, 0, 0);
                  accL[nh] = __builtin_amdgcn_mfma_f32_16x16x32_bf16(__builtin_bit_cast(bf16x8, ah), __builtin_bit_cast(bf16x8, wl[s][nh]), accL[nh], 0, 0, 0);
                  accL[nh] = __builtin_amdgcn_mfma_f32_16x16x32_bf16(__builtin_bit_cast(bf16x8, al), __builtin_bit_cast(bf16x8, wh[s][nh]), accL[nh], 0, 0, 0); } }
#pragma unroll
          for (int nh = 0; nh < 2; ++nh)
#pragma unroll
              for (int i = 0; i < 4; ++i) red[(F.wave * 16 + 4 * fq + i) * 32 + 16 * nh + fn] = accL[nh][i]; }
        __syncthreads();
        { const int r = 2 * F.wave + kh, tl = gi * 16 + r; float s = rbe;
#pragma unroll
          for (int p = 0; p < 8; ++p) s += red[(p * 16 + r) * 32 + e];
          float tv[4]; int ti[4];
#pragma unroll
          for (int j = 0; j < 4; ++j) { float bvv = s; int bi = e;
#define RT_STEP(GETV, GETI) do { const float ov = GETV; const int oi = GETI; if (ov > bvv || (ov == bvv && oi < bi)) { bvv = ov; bi = oi; } } while (0)
#define RT_DPP(x_, c_) __builtin_amdgcn_update_dpp(0, (x_), (c_), 0xf, 0xf, false)
              RT_STEP(__int_as_float(RT_DPP(__float_as_int(bvv), 0xB1)), RT_DPP(bi, 0xB1));
              RT_STEP(__int_as_float(RT_DPP(__float_as_int(bvv), 0x4E)), RT_DPP(bi, 0x4E));
              RT_STEP(__int_as_float(RT_DPP(__float_as_int(bvv), 0x141)), RT_DPP(bi, 0x141));
              RT_STEP(__int_as_float(RT_DPP(__float_as_int(bvv), 0x140)), RT_DPP(bi, 0x140));
              RT_STEP(__int_as_float(__builtin_amdgcn_ds_swizzle(__float_as_int(bvv), 0x401F)), __builtin_amdgcn_ds_swizzle(bi, 0x401F));
#undef RT_STEP
#undef RT_DPP
              tv[j] = bvv; ti[j] = bi; if (e == bi) s = -INFINITY; }
          const float e1 = expf(tv[1] - tv[0]), e2 = expf(tv[2] - tv[0]), e3 = expf(tv[3] - tv[0]); const float inv = 1.0f / (1.0f + e1 + e2 + e3);
          if (e < 4 && !dry) { const int me = (e == 0) ? ti[0] : (e == 1) ? ti[1] : (e == 2) ? ti[2] : ti[3]; const float mg = ((e == 0) ? 1.0f : (e == 1) ? e1 : (e == 2) ? e2 : e3) * inv;
              const unsigned lp = __hip_atomic_fetch_add((LAS unsigned*)&lcnt[me], 1u, __ATOMIC_RELAXED, __HIP_MEMORY_SCOPE_WORKGROUP); tabE[tl * 4 + e] = me; tabP[tl * 4 + e] = (int)lp; tabG[tl * 4 + e] = mg; } }
    }
    __syncthreads();
    if (dry) return;
    if (F.tid < NE) gbase[F.tid] = __hip_atomic_fetch_add(F.ctl + CW_CNT + (l * NE + F.tid) * 64, lcnt[F.tid], RLX_AGENT);
    __syncthreads();
    { const int ntok = gn_ * 16; int* slot_e = WSP(int, WS_SLOT_E); int* slot_pos = WSP(int, WS_SLOT_POS); float* slot_gate = WSP(float, WS_SLOT_GATE);
      for (int i = F.tid; i < ntok * 4; i += NWAVES * 64) { const int tl = i >> 2; const int m = (g0 + (tl >> 4)) * 16 + (tl & 15);
          const int ee = tabE[i], pp = (int)gbase[ee] + tabP[i]; slot_e[(size_t)m * 4 + (i & 3)] = ee; slot_pos[(size_t)m * 4 + (i & 3)] = pp; slot_gate[(size_t)m * 4 + (i & 3)] = tabG[i];
          WSP(int, WS_XG)[(size_t)ee * TOK_CAP + pp] = m; } }
    __syncthreads();
}

__device__ __forceinline__ void moe_offsets(Frame& F, int l) {
    if (F.tid < 64) {
        const unsigned c = (F.tid < NE) ? __hip_atomic_load(F.ctl + CW_CNT + (l * NE + F.tid) * 64, RLX_AGENT) : 0u;
        const unsigned t = (c + 255u) >> 8; unsigned s = t;
#pragma unroll
        for (int o = 1; o < 32; o <<= 1) { const unsigned v = __shfl_up(s, o); if ((F.tid & 63) >= o) s += v; }
        if (F.tid < NE) { F.MISC[F.tid] = s - t; F.MISC[40 + F.tid] = (s - t) * 256u; }
        if (F.tid == NE - 1) F.MISC[32] = s; }
    __syncthreads();
}
__device__ __forceinline__ void slot_rows_pass(Frame& F, int l) {
    const int* slot_e = WSP(const int, WS_SLOT_E); const int* slot_pos = WSP(const int, WS_SLOT_POS); const float* slot_gate = WSP(const float, WS_SLOT_GATE);
    int* slot_row = WSP(int, WS_SLOT_ROW); float* rgate = WSP(float, WS_RGATE);
    for (int a = (int)blockIdx.x * (NWAVES * 64) + F.tid; a < T * TOPK; a += F.G * NWAVES * 64) {
        const int row = (int)F.MISC[40 + slot_e[a]] + slot_pos[a]; rgate[row] = slot_gate[a]; slot_row[a] = row; }
}
__device__ __forceinline__ void knorm_pass(Frame& F, int l) {
    volatile LAS unsigned* kred = F.MISC + 224;
    const bf16* K = WSP(const bf16, WS_K);
    for (int ch = (int)blockIdx.x; ch < T / 128; ch += F.G) {
        if (F.tid < 16) kred[F.tid] = 0u;
        __syncthreads();
        float mx = 0.f;
#pragma unroll 4
        for (int i = 0; i < 16; ++i) { const size_t off = (size_t)(ch * 128 + F.wave * 16 + i) * D + 16 * F.lane;
            const v4u a0 = *(const GAS v4u*)(K + off), a1 = *(const GAS v4u*)(K + off + 8); float s = 0.f;
#pragma unroll
            for (int k = 0; k < 4; ++k) { const float x0 = bflo(a0[k]), x1 = bfhi(a0[k]), x2 = bflo(a1[k]), x3 = bfhi(a1[k]); s += (x0 * x0 + x1 * x1) + (x2 * x2 + x3 * x3); }
            s += __shfl_xor(s, 1); s += __shfl_xor(s, 2); mx = fmaxf(mx, s); }
        if ((F.lane & 3) == 0) __hip_atomic_fetch_max((LAS unsigned*)&kred[F.lane >> 2], __float_as_uint(mx), __ATOMIC_RELAXED, __HIP_MEMORY_SCOPE_WORKGROUP);
        __syncthreads();
        if (F.tid < 16) __hip_atomic_fetch_max(F.ctl + CW_KMAX + ((l * BATCH + (ch * 128) / SEQ) * 16 + F.tid) * 16, kred[F.tid], RLX_AGENT);
        __syncthreads();
    }
}


#ifndef MK_REP
#define MK_REP 0
#endif
#ifndef MK_VAR
#define MK_VAR 0
#endif
#ifndef MK_DIS
#define MK_DIS 0
#endif
#ifndef MK_PER_STEP
#define MK_PER_STEP 0
#endif
#ifndef MK_XCID
#define MK_XCID 1
#endif
#ifndef MK_A_EARLY
#define MK_A_EARLY true
#endif
#ifndef MK_SB_EARLY
#define MK_SB_EARLY true
#endif
constexpr int SPL = 10, N_STEPS = 3 + SPL * DEPTH;
struct Args { const float* in[23]; float* out; unsigned char* ws; int st_lo, st_hi, pad0, pad1; };
static_assert(sizeof(Args) == 23 * 8 + 8 + 8 + 16, "Args has no padding bytes");

__global__ void __launch_bounds__(NWAVES * 64, 2) mk_fwd(Args args) {
    extern __shared__ __attribute__((aligned(16))) unsigned char lds[];
    Frame F;
    F.lds = (LAS unsigned char*)lds;
    F.MISC = (volatile LAS unsigned*)(F.lds + MISC_OFF);
    F.tid = threadIdx.x; F.lane = F.tid & 63; F.wave = __builtin_amdgcn_readfirstlane(F.tid >> 6);
    const int wave0 = F.wave;
    F.G = gridDim.x; { const int bx = blockIdx.x; F.vcu = (F.G % 8 == 0) ? (bx % 8) * (F.G / 8) + bx / 8 : bx; }
    F.ws = args.ws; F.ctl = (gu32*)(args.ws + WS_CTL);
    for (int u = F.tid; u < 176; u += NWAVES * 64) F.MISC[u] = 0u;
    if (F.tid == 0) F.MISC[241] = 0u;
    if (F.tid < 24) { const unsigned long long p = (F.tid < 23) ? (unsigned long long)args.in[F.tid] : (unsigned long long)args.out; F.MISC[176 + 2 * F.tid] = (unsigned)p; F.MISC[177 + 2 * F.tid] = (unsigned)(p >> 32); }
    __syncthreads();
    if (F.tid == 0) { const unsigned xc = xb_xcc_id() & 7u; F.MISC[242] = xc; F.MISC[243] = __hip_atomic_fetch_add(F.ctl + CW_XRANK + 64 * xc, 1u, RLX_AGENT); }
    __syncthreads();
    int cid = (int)blockIdx.x;
    const int lo = args.st_lo, hi = args.st_hi;
    XcdBarrier bar; bar.bar = (unsigned*)(args.ws + WS_CTL) + CW_BAR; bar.x = 0; bar.st = nullptr;
    if (hi - lo > 1) bar = xcd_barrier_post((unsigned*)(args.ws + WS_CTL) + CW_BAR, F.MISC + 160);
#define IN(k) (lo <= (k) && (k) < hi)
#define REFRESH() do { int t_; asm volatile("v_mbcnt_lo_u32_b32 %0, -1, 0\n\tv_mbcnt_hi_u32_b32 %0, -1, %0\n\tv_lshl_add_u32 %0, %1, 6, %0" : "=&v"(t_) : "s"(wave0)); F.tid = t_; F.lane = t_ & 63; F.wave = wave0; } while (0)
#define SEAM(k) do { if (IN(k) && IN((k) + 1)) { xcd_barrier(bar); if (MK_REP & 4096) xcd_barrier(bar); } } while (0)
#define SEAM_IF(k, c) do { if ((c) && IN(k) && IN((k) + 1)) { xcd_barrier(bar); if (MK_REP & 4096) xcd_barrier(bar); } } while (0)

    for (int rep = 0; rep < ((MK_REP & 1) ? 2 : 1); ++rep) if (IN(0) && !(MK_DIS & 1)) { REFRESH(); p0_prologue(F); }
    SEAM(0);
    if (MK_XCID && IN(0) && IN(1) && (F.G % 8) == 0) {
        bool even = true;
#pragma unroll
        for (int x = 0; x < 8; ++x) even = even && (__hip_atomic_load(F.ctl + CW_XRANK + 64 * x, RLX_AGENT) == (unsigned)(F.G / 8));
        if (even) { cid = __builtin_amdgcn_readfirstlane((int)(F.MISC[243] * 8u + F.MISC[242])); F.vcu = (cid % 8) * (F.G / 8) + cid / 8; }
    }
    if (IN(1)) { REFRESH(); mod_reduce_pass(F); }
    SEAM(1);
    for (int l = 0; l < DEPTH; ++l) {
        const int sb = 2 + SPL * l;
        const bool isA = (l < 2);
        if ((MK_REP & 2) && IN(sb + 0)) { REFRESH(); if (l == 0) norm_combine_pass(F, 0, true); else norm_combine_pass8(F, l, true); }
        if (IN(sb + 0) && !(MK_DIS & 2)) { REFRESH(); if (l == 0) norm_combine_pass(F, 0); else norm_combine_pass8(F, l); }
        SEAM(sb + 0);
        for (int rep = 0; rep < ((MK_REP & 4) ? 2 : 1); ++rep)
        if (IN(sb + 1) && !(MK_DIS & 4)) {
            if (isA) {
                pg8::Gemm g{WSP(const bf16, WS_H), WSP(const bf16, WS_WQKV) + (size_t)l * 3 * D * D, T, 3 * D, D}; pg8::StaticOrder S; S.init(T, 3 * D, F.G, cid);
                pg8::EpiBf16 E{WSP(bf16, WS_Q), D, D, (size_t)(WS_K - WS_Q) / 2, QSCALE, (unsigned*)(F.ws + WS_CTL) + CW_KMAX + (size_t)l * BATCH * 16 * 16, SEQ};
                pg8::gemm_phase<pg8::EpiBf16, pg8::StaticOrder, true, true>(F.lds + RING_OFF, g, S, E, wave0);
            } else {
                { pg8::Gemm g{WSP(const bf16, WS_H), WSP(const bf16, WS_WQB) + (size_t)(l - 2) * D * D, T, D, D}; pg8::StaticOrder S; S.init(T, D, F.G, cid);
                  pg8::EpiBf16 E{WSP(bf16, WS_Q), D, D, 0, QSCALE, nullptr, SEQ};
                  pg8::gemm_phase<pg8::EpiBf16, pg8::StaticOrder, true, true>(F.lds + RING_OFF, g, S, E, wave0); }
                if (l == 2) {
                    __syncthreads();
                    pg8::Gemm g{WSP(const bf16, WS_HKV), WSP(const bf16, WS_WKV), T, 2 * D, D}; pg8::StaticOrder S; S.init(T, 2 * D, F.G, cid);
                    pg8::EpiBf16 E{WSP(bf16, WS_KSH), D, D, (size_t)(WS_VSH - WS_KSH) / 2, 1.0f, nullptr, SEQ};
                    pg8::gemm_phase<pg8::EpiBf16, pg8::StaticOrder, true, true>(F.lds + RING_OFF, g, S, E, wave0); }
            }
        }
        SEAM(sb + 1);
        for (int rep = 0; rep < (((MK_REP & 8) && isA) || ((MK_REP & 16) && !isA) ? 2 : 1); ++rep)
        if (IN(sb + 3)) {
            REFRESH();
            if (isA && !(MK_DIS & 8)) {
                const float lam_init = (l == 0) ? 0.2f : (0.8f - 0.6f * 0.74081822068171788f);
                float lam; { const float* lv = FIN(I_ALAM) + (size_t)l * 256; const int ln = F.tid & 63;
                    const float s01 = wave_sum(lv[ln] * lv[64 + ln]), s23 = wave_sum(lv[128 + ln] * lv[192 + ln]); lam = expf(s01) - expf(s23) + lam_init; }
                LAS float* gsl = (LAS float*)(F.lds + TAB_OFF);
                if (F.tid < 128) gsl[F.tid] = FIN(I_ASUBLN)[(size_t)l * 128 + F.tid] * (1.0f - lam_init);
                LAS float* ktab = gsl + 128;
                if (F.tid >= 128 && F.tid < 256) ktab[F.tid - 128] = __uint_as_float(__hip_atomic_load(F.ctl + CW_KMAX + ((l * BATCH * 16) + ((F.tid - 128) >> 1)) * 16 + ((F.tid - 128) & 1), RLX_AGENT));
                constexpr int AQ_N = 224;
                const int xcc = __builtin_amdgcn_readfirstlane((int)(xb_xcc_id() & 7u));
                int kq = 0, qx = xcc, qmask = 0xff;
                if (F.tid == 0) F.MISC[240] = __hip_atomic_fetch_add(F.ctl + CW_AQ + 64 * (8 * l + qx), 1u, RLX_AGENT);
                __syncthreads();
                int cur = __builtin_amdgcn_readfirstlane((int)F.MISC[240]), ucount = 0;
                __syncthreads();
                for (;;) {
                    if (cur >= AQ_N && kq == 0) {
                        if (F.tid < 64) { int t8 = F.tid; asm volatile("" : "+v"(t8));
                            const unsigned hq = (t8 < 8) ? __hip_atomic_load(F.ctl + CW_AQ + 64 * (8 * l + ((xcc + t8) & 7)), RLX_AGENT) : 0xffffffffu;
                            const unsigned long long bal = __ballot(hq < (unsigned)AQ_N); if (F.tid == 0) F.MISC[244] = (unsigned)bal; }
                        __syncthreads(); qmask = __builtin_amdgcn_readfirstlane((int)F.MISC[244]); __syncthreads();
                    }
                    while (cur >= AQ_N && kq < 7) {
                        ++kq; if (!((qmask >> kq) & 1)) continue; qx = (xcc + kq) & 7;
                        if (F.tid == 0) F.MISC[240] = __hip_atomic_fetch_add(F.ctl + CW_AQ + 64 * (8 * l + qx), 1u, RLX_AGENT);
                        __syncthreads();
                        cur = __builtin_amdgcn_readfirstlane((int)F.MISC[240]);
                        __syncthreads();
                    }
                    if (cur >= AQ_N) break;
                    if (cur < 192 && (cur & 1)) {
                        expert_conv_unit(F, l, qx * 96 + (cur >> 1));
                        __syncthreads();
                        if (F.tid == 0) F.MISC[240] = __hip_atomic_fetch_add(F.ctl + CW_AQ + 64 * (8 * l + qx), 1u, RLX_AGENT);
                        __syncthreads();
                        cur = __builtin_amdgcn_readfirstlane((int)F.MISC[240]);
                        __syncthreads();
                        continue;
                    }
                    const int aidx = (cur < 192) ? (cur >> 1) : cur - 96;
                    int b, head, qb; att::unit_of_Aq(qx, aidx, b, head, qb);
                    const float s2 = LOG2E * __builtin_amdgcn_exp2f(-(float)(head + 1));
                    for (int r = 0; r < 2; ++r) {
                        const att::Tensors Tn{WSP(const bf16, WS_Q), WSP(const bf16, WS_K), WSP(const bf16, WS_V), WSP(bf16, WS_OC)};
                        const float kmax = sqrtf(ktab[(b * 16 + head * 2 + r) * 2] + ktab[(b * 16 + head * 2 + r) * 2 + 1]);
                        att::attn_unit<0, MK_A_EARLY>(Tn, b, head * 128 + r * 64, head * 128 + r * 64, head * 128, head * 128, qb, s2, kmax, ucount, wave0, (LAS char*)(F.lds + RING_OFF), r, lam, (const float*)gsl);
                        ++ucount;
                    }
                    if (F.tid == 0) F.MISC[240] = __hip_atomic_fetch_add(F.ctl + CW_AQ + 64 * (8 * l + qx), 1u, RLX_AGENT);
                    __syncthreads();
                    cur = __builtin_amdgcn_readfirstlane((int)F.MISC[240]);
                    __syncthreads();
                }
            } else if (!isA && !(MK_DIS & 16)) {
                const int xcc = __builtin_amdgcn_readfirstlane((int)(xb_xcc_id() & 7u));
                int ucount = 0;
                int qmask = 0xff;
                for (int kq = 0; kq < 8; ++kq) {
                    if (kq == 1) {
                        if (F.tid < 64) { const unsigned hq = (F.tid < 8) ? __hip_atomic_load(F.ctl + CW_AQ + 64 * (16 * l + ((xcc + F.tid) & 7)), RLX_AGENT) : 0xffffffffu;
                            const unsigned long long bal = __ballot(hq < 256u); if (F.tid == 0) F.MISC[244] = (unsigned)bal; }
                        __syncthreads(); qmask = __builtin_amdgcn_readfirstlane((int)F.MISC[244]); __syncthreads();
                    }
                    if (!((qmask >> kq) & 1)) continue;
                    const int qx = (xcc + kq) & 7; int cur;
                    if (F.tid == 0) F.MISC[240] = __hip_atomic_fetch_add(F.ctl + CW_AQ + 64 * (16 * l + qx), 1u, RLX_AGENT);
                    __syncthreads(); cur = __builtin_amdgcn_readfirstlane((int)F.MISC[240]); __syncthreads();
                    while (cur < 256) {
                        unsigned nxt = 0u; if (F.tid == 0) nxt = __hip_atomic_fetch_add(F.ctl + CW_AQ + 64 * (16 * l + qx), 1u, RLX_AGENT);
                        const int inst = qx * 8 + (cur >> 5), qb = 31 - (cur & 31), b = inst >> 4, h = inst & 15;
                        const att::Tensors Tn{WSP(const bf16, WS_Q), WSP(const bf16, WS_KSH), WSP(const bf16, WS_VSH), WSP(bf16, WS_O0)};
                        att::attn_unit<1, MK_SB_EARLY>(Tn, b, h * 64, h * 64, h * 64, h * 64, qb, 0.f, 0.f, ucount, wave0, (LAS char*)(F.lds + RING_OFF));
                        ++ucount;
                        if (F.tid == 0) F.MISC[240] = nxt;
                        __syncthreads(); cur = __builtin_amdgcn_readfirstlane((int)F.MISC[240]); __syncthreads();
                    }
                }
            }
            __syncthreads();
        }
        SEAM(sb + 3);
        if (IN(sb + 5) && !(MK_DIS & 64)) {
            pg8::Gemm g{isA ? WSP(const bf16, WS_OC) : WSP(const bf16, WS_O0), isA ? WSP(const bf16, WS_WOA) + (size_t)l * D * D : WSP(const bf16, WS_WOB) + (size_t)(l - 2) * D * D, T, D, D};
            pg8::StaticOrder S; S.init(T, D, F.G, cid);
            pg8::EpiResid E{(l == 0) ? FIN(I_X) : (const float*)nullptr, WSP(const unsigned short, WS_XCUR), WSP(unsigned short, WS_XCUR), WSP(const float, WS_MOD) + (size_t)l * BATCH * 6 * D + 2 * D, 6 * D, SEQ, D};
            if (MK_REP & 64) { pg8::EpiResid E2{(l == 0) ? FIN(I_X) : (const float*)nullptr, WSP(const unsigned short, WS_XCUR), WSP(unsigned short, WS_ACT), WSP(const float, WS_MOD) + (size_t)l * BATCH * 6 * D + 2 * D, 6 * D, SEQ, D};
                pg8::gemm_phase<pg8::EpiResid, pg8::StaticOrder, true, true>(F.lds + RING_OFF, g, S, E2, wave0); __syncthreads(); }
            pg8::gemm_phase<pg8::EpiResid, pg8::StaticOrder, true, true>(F.lds + RING_OFF, g, S, E, wave0);
        }
        SEAM(sb + 5);
        if ((MK_REP & 128) && IN(sb + 6)) { REFRESH(); router_pass(F, l, true); }
        if (IN(sb + 6) && !(MK_DIS & 128)) { REFRESH(); router_pass(F, l); }
        SEAM(sb + 6);
        for (int rep = 0; rep < ((MK_REP & 512) ? 2 : 1); ++rep)
        if (IN(sb + 8) && !(MK_DIS & 512)) {
            REFRESH(); moe_offsets(F, l);
            if (rep == 0) slot_rows_pass(F, l);
            pg8::Gemm g{(const bf16*)WSP(const unsigned char, WS_H), (const bf16*)(WSP(const unsigned char, WS_WGU) + (size_t)l * NE * 2 * D * D), XG_ROWS, NE * 2 * D, D / 2};
            pg8::GroupedOrder S{(const LAS int*)(F.lds + MISC_OFF), 8, F.G, cid, TOK_CAP};
            pg8::EpiSwiglu E{WSP(unsigned char, WS_ACT), FIN(I_BGU) + (size_t)l * NE * 2 * D};
            pg8::gemm_phase<pg8::EpiSwiglu, pg8::GroupedOrder, true, true, true, true>(F.lds + RING_OFF, g, S, E, wave0, WSP(const int, WS_XG), (LAS int*)(F.lds + TAB_OFF));
        }
        SEAM(sb + 8);
        for (int rep = 0; rep < ((MK_REP & 1024) ? 2 : 1); ++rep)
        if (IN(sb + 9) && !(MK_DIS & 1024)) {
            REFRESH(); moe_offsets(F, l);
            pg8::Gemm g{(const bf16*)WSP(const unsigned char, WS_ACT), (const bf16*)(WSP(const unsigned char, WS_WD) + (size_t)l * NE * D * D), XG_ROWS, NE * D, D / 2};
            pg8::GroupedOrder S{(const LAS int*)(F.lds + MISC_OFF), 4, F.G, cid, TOK_CAP};
            pg8::EpiDown E{WSP(unsigned char, WS_YS), FIN(I_BD) + (size_t)l * NE * D, WSP(const float, WS_RGATE)};
            pg8::gemm_phase<pg8::EpiDown, pg8::GroupedOrder, true, true, true>(F.lds + RING_OFF, g, S, E, wave0);
        }
        SEAM(sb + 9);
    }
    { int lo_ = lo, hi_ = hi; asm volatile("" : "+s"(lo_), "+s"(hi_));
      if (lo_ <= N_STEPS - 1 && N_STEPS - 1 < hi_) { REFRESH(); norm_combine_pass8(F, DEPTH); } }
#undef IN
#undef SEAM
}

extern "C" void kernel_launch(void* const* d_in, const int* in_sizes, int n_in, void* d_out, int out_size, void* d_ws, size_t ws_size, hipStream_t stream) {
    static int grid = 0;
    if (grid == 0) {
        if (n_in != 23 || in_sizes[0] != T * D || out_size != T * D || ws_size < WS_END) { fprintf(stderr, "kernel_launch: unexpected shapes / workspace (n_in %d, in0 %d, out %d, ws %zu < %zu); nothing launched\n", n_in, n_in > 0 ? in_sizes[0] : -1, out_size, ws_size, (size_t)WS_END); grid = -1; return; }
        int dev = 0, cus = 0, per_cu = 0;
        if (hipGetDevice(&dev) != hipSuccess || hipDeviceGetAttribute(&cus, hipDeviceAttributeMultiprocessorCount, dev) != hipSuccess) { fprintf(stderr, "kernel_launch: device query failed\n"); grid = -1; return; }
        if (hipFuncSetAttribute((const void*)mk_fwd, hipFuncAttributeMaxDynamicSharedMemorySize, LDS_BYTES) != hipSuccess) { fprintf(stderr, "kernel_launch: hipFuncSetAttribute failed\n"); grid = -1; return; }
        if (hipOccupancyMaxActiveBlocksPerMultiprocessor(&per_cu, (const void*)mk_fwd, NWAVES * 64, LDS_BYTES) != hipSuccess || per_cu < 1) { fprintf(stderr, "kernel_launch: occupancy query reports %d workgroups per CU\n", per_cu); }
        (void)hipGetLastError();
        grid = cus;
    }
    if (grid < 0) return;
    if (hipMemsetAsync((char*)d_ws + WS_CTL, 0, CTL_ZERO_BYTES, stream) != hipSuccess) { fprintf(stderr, "kernel_launch: memset failed\n"); return; }
    Args a{};
    for (int i = 0; i < 23; ++i) a.in[i] = (const float*)d_in[i];
    a.out = (float*)d_out; a.ws = (unsigned char*)d_ws;
#if MK_PER_STEP
    for (int s = 0; s < N_STEPS; ++s) { a.st_lo = s; a.st_hi = s + 1; hipLaunchKernelGGL(mk_fwd, dim3(grid), dim3(NWAVES * 64), LDS_BYTES, stream, a); }
#else
    a.st_lo = 0; a.st_hi = N_STEPS; hipLaunchKernelGGL(mk_fwd, dim3(grid), dim3(NWAVES * 64), LDS_BYTES, stream, a);
#endif
    const hipError_t le = hipPeekAtLastError();
    if (le != hipSuccess) fprintf(stderr, "kernel_launch: launch failed: %s\n", hipGetErrorName(le));
}
```
